# Optimizing an MI355X kernel written in HIP

```python
import jax, jax.numpy as jnp
from jax import lax
import numpy as np

D_MODEL = 1024
BATCH = 8
SEQ = 4096
DEPTH = 2

D_MIX = D_MODEL
D_FOURIER = D_MIX // 2
F_GROUPS = 4
F_GROUP_DIM = D_FOURIER // F_GROUPS
D_GLA_V = D_MIX - D_FOURIER
GLA_HEADS = 4
DV_HEAD = D_GLA_V // GLA_HEADS
DK_HEAD = DV_HEAD // 2
D_GLA_K = GLA_HEADS * DK_HEAD
GATE_RANK = 16
GATE_LOGIT_NORMALIZER = 16.0
CHUNK = 64
D_FF = -(-8 * D_MODEL // (3 * 256)) * 256
EPS = 1e-6
IN_SIZES = (D_FOURIER, D_GLA_K, D_GLA_K, D_GLA_V, D_GLA_V, GATE_RANK, GATE_RANK)
IN_COLS = sum(IN_SIZES)
IN_OFFSETS = tuple(int(o) for o in np.cumsum(IN_SIZES)[:-1])

kernel_name = "hybrid_fnet_gla_sandwich_encoder"


def rmsnorm(x, w):
    xf = x.astype(jnp.float32)
    y = xf * lax.rsqrt(jnp.mean(xf * xf, axis=-1, keepdims=True) + EPS)
    return (y * w.astype(jnp.float32)).astype(x.dtype)


def fourier_mix(u):
    b, s, _ = u.shape
    uf = u.astype(jnp.float32).reshape(b, s, F_GROUPS, F_GROUP_DIM)
    y = jnp.fft.fftn(uf, axes=(1, 3), norm="ortho").real
    return y.reshape(b, s, D_FOURIER).astype(u.dtype)


def gla_chunked(q, k, v, log_a):
    b, h, s, dk = q.shape
    dv = v.shape[-1]
    n = s // CHUNK
    q = q.reshape(b, h, n, CHUNK, dk)
    k = k.reshape(b, h, n, CHUNK, dk)
    v = v.reshape(b, h, n, CHUNK, dv)
    cum = jnp.cumsum(log_a.reshape(b, h, n, CHUNK, dk), axis=3)
    cum_last = cum[:, :, :, -1:, :]
    q_e = q * jnp.exp(cum)
    k_e = k * jnp.exp(-cum)
    k_end = k * jnp.exp(cum_last - cum)
    mask = jnp.tril(jnp.ones((CHUNK, CHUNK), dtype=bool))
    att = jnp.where(mask, jnp.einsum('bhnid,bhnjd->bhnij', q_e, k_e), 0.0)
    o_intra = jnp.einsum('bhnij,bhnjv->bhniv', att, v)
    chunk_state = jnp.einsum('bhnjd,bhnjv->bhndv', k_end, v)
    decay = jnp.exp(cum_last[:, :, :, 0, :])

    def step(state, inp):
        dec, cs = inp
        return state * dec[..., None] + cs, state

    init = jnp.zeros((b, h, dk, dv), q.dtype)
    _, prev = lax.scan(step, init, (jnp.moveaxis(decay, 2, 0), jnp.moveaxis(chunk_state, 2, 0)))
    prev = jnp.moveaxis(prev, 0, 2)
    o_inter = jnp.einsum('bhnid,bhndv->bhniv', q_e, prev)
    return (o_intra + o_inter).reshape(b, h, s, dv)


def gla_bidirectional(h_in, qp, kp, vp, gp, af, ab, w_af, b_af, w_ab, b_ab, w_onorm):
    b, s, _ = qp.shape
    dt = qp.dtype
    heads = lambda t, d: t.astype(jnp.float32).reshape(b, s, GLA_HEADS, d).transpose(0, 2, 1, 3)
    q = heads(qp, DK_HEAD) * (DK_HEAD ** -0.5)
    k = heads(kp, DK_HEAD)
    v = heads(vp, DV_HEAD)
    la_f = jax.nn.log_sigmoid((af @ w_af + b_af).astype(jnp.float32)) / GATE_LOGIT_NORMALIZER
    la_b = jax.nn.log_sigmoid((ab @ w_ab + b_ab).astype(jnp.float32)) / GATE_LOGIT_NORMALIZER
    la_f = heads(la_f, DK_HEAD)
    la_b = heads(la_b, DK_HEAD)
    o_fwd = gla_chunked(q, k, v, la_f)
    flip = lambda t: jnp.flip(t, axis=2)
    o_bwd = flip(gla_chunked(flip(q), flip(k), flip(v), flip(la_b)))
    o = (o_fwd + o_bwd).transpose(0, 2, 1, 3)
    o = rmsnorm(o, w_onorm)
    g = jax.nn.silu(gp.astype(jnp.float32)).reshape(b, s, GLA_HEADS, DV_HEAD)
    return (o * g).reshape(b, s, D_GLA_V).astype(dt)


def setup_inputs(seed: int = 0) -> dict:
    key = jax.random.key(seed)
    ks = jax.random.split(key, 16)
    nrm = lambda k, shape, scale: jax.random.normal(k, shape, jnp.float32) * scale
    gain = lambda k: 1.0 + 0.02 * jax.random.normal(k, (DEPTH, D_MODEL), jnp.float32)
    return {
        "x": jax.random.normal(ks[0], (BATCH, SEQ, D_MODEL), jnp.float32),
        "norm_mix_pre": gain(ks[1]),
        "w_in": nrm(ks[2], (DEPTH, D_MODEL, IN_COLS), D_MODEL ** -0.5),
        "w_alpha_fwd": nrm(ks[3], (DEPTH, GATE_RANK, D_GLA_K), GATE_RANK ** -0.5),
        "b_alpha_fwd": nrm(ks[4], (DEPTH, D_GLA_K), 0.1),
        "w_alpha_bwd": nrm(ks[5], (DEPTH, GATE_RANK, D_GLA_K), GATE_RANK ** -0.5),
        "b_alpha_bwd": nrm(ks[6], (DEPTH, D_GLA_K), 0.1),
        "gla_out_norm": 1.0 + 0.02 * jax.random.normal(ks[7], (DEPTH, DV_HEAD), jnp.float32),
        "w_out": nrm(ks[8], (DEPTH, D_MIX, D_MODEL), D_MIX ** -0.5),
        "norm_mix_post": gain(ks[9]),
        "norm_ffn_pre": gain(ks[10]),
        "w_ffn_gate": nrm(ks[11], (DEPTH, D_MODEL, D_FF), D_MODEL ** -0.5),
        "w_ffn_up": nrm(ks[12], (DEPTH, D_MODEL, D_FF), D_MODEL ** -0.5),
        "w_ffn_down": nrm(ks[13], (DEPTH, D_FF, D_MODEL), D_FF ** -0.5),
        "norm_ffn_post": gain(ks[14]),
    }


def reference(x, norm_mix_pre, w_in, w_alpha_fwd, b_alpha_fwd, w_alpha_bwd, b_alpha_bwd,
              gla_out_norm, w_out, norm_mix_post, norm_ffn_pre, w_ffn_gate, w_ffn_up,
              w_ffn_down, norm_ffn_post):
    for l in range(DEPTH):
        h = rmsnorm(x, norm_mix_pre[l])
        p = h @ w_in[l]
        fp, qp, kp, vp, gp, af, ab = jnp.split(p, IN_OFFSETS, axis=-1)
        y_f = fourier_mix(fp)
        y_g = gla_bidirectional(h, qp, kp, vp, gp, af, ab, w_alpha_fwd[l], b_alpha_fwd[l],
                                w_alpha_bwd[l], b_alpha_bwd[l], gla_out_norm[l])
        m = jnp.concatenate([y_f, y_g], axis=-1) @ w_out[l]
        x = x + rmsnorm(m, norm_mix_post[l])
        h2 = rmsnorm(x, norm_ffn_pre[l])
        f = (jax.nn.silu(h2 @ w_ffn_gate[l]) * (h2 @ w_ffn_up[l])) @ w_ffn_down[l]
        x = x + rmsnorm(f, norm_ffn_post[l])
    return x
```

```cpp
#include <hip/hip_runtime.h>
#include <hip/hip_cooperative_groups.h>
#include <cstdio>
namespace cg = cooperative_groups;

#ifndef ONE_LAUNCH
#define ONE_LAUNCH 1
#endif

#ifndef PROBE_DBL
#define PROBE_DBL 0
#endif
#define LAS __attribute__((address_space(3)))
typedef unsigned short bf16_t;
typedef short bf16x8 __attribute__((ext_vector_type(8)));
typedef float f32x4 __attribute__((ext_vector_type(4)));
typedef unsigned u32x4 __attribute__((ext_vector_type(4)));
typedef unsigned u32x2 __attribute__((ext_vector_type(2)));

constexpr int DM = 1024, SEQ = 4096, NTOK = 32768, DFF = 2816, INC = 2080, NLAYER = 2;
constexpr int LDS_STAGE = 131072;
constexpr int LDS_TAB = LDS_STAGE + 16;
constexpr int LDS_BYTES = LDS_TAB + 16384 + 8704;
constexpr int NTHREADS = 512;
constexpr size_t W_IN = 0, W_OUT = 3145728, W_GU = 4194304, W_D = 9961472, W_LAYER = 12845056;

struct Params {
    const float *x, *norm_mix_pre, *w_in, *w_af, *b_af, *w_ab, *b_ab, *onorm, *w_out, *norm_mix_post, *norm_ffn_pre, *w_g, *w_u, *w_d, *norm_ffn_post;
    float* out;
    bf16_t *Wt, *FT, *XB, *MIX, *MF, *GT, *Q, *K, *V, *G, *LAF, *LAB, *CSF, *CSB, *HMID;
    float *rstd, *ssqp, *decf, *decb;
    unsigned* bar;
};

__device__ __forceinline__ int tid_() { int t = threadIdx.x; asm volatile("" : "+v"(t)); return t; }
__device__ __forceinline__ float bf2f(unsigned b) { return __uint_as_float(b << 16); }
__device__ __forceinline__ float bflo(unsigned w) { return __uint_as_float(w << 16); }
__device__ __forceinline__ float bfhi(unsigned w) { return __uint_as_float(w & 0xffff0000u); }
typedef __bf16 bf2_t __attribute__((ext_vector_type(2)));
typedef float f2_t __attribute__((ext_vector_type(2)));
__device__ __forceinline__ unsigned pk2(float lo, float hi) { f2_t f = {lo, hi}; bf2_t b = __builtin_convertvector(f, bf2_t); return __builtin_bit_cast(unsigned, b); }
__device__ __forceinline__ bf16_t f2bf(float f) { return (bf16_t)(pk2(f, 0.f) & 0xffffu); }

namespace pg8 {
constexpr int BM = 256, BK = 64, HALF = 128, HTB = HALF * BK * 2, NXCD = 8, WGM = 8;
__device__ __forceinline__ int lds_byte(int r, int c) { const int st = (r >> 4) * 2 + (c >> 5), rr = r & 15, cc = c & 31, ob = rr * 64 + cc * 2; return st * 1024 + (ob ^ (((ob >> 9) & 1) << 5)); }
__device__ __forceinline__ void stage_rc(int b, int& R, int& C) { const int st = b / 1024, sb = b % 1024, swz = sb ^ (((sb >> 9) & 1) << 5); R = (st >> 1) * 16 + swz / 64; C = (st & 1) * 32 + (swz % 64) / 2; }
__device__ __forceinline__ int perm32(int rho) { const int n = rho >> 4, i = rho & 15; return 8 * (i >> 2) + 4 * n + (i & 3); }
struct Unit { int pm, pn; };
struct Gemm { const bf16_t* A; const bf16_t* Bt; int M, N, K; };
struct StaticOrder {
    int nM, nN, nwg, G, c;
    __device__ void init(int M, int N, int G_, int c_) { nM = M / BM; nN = N / BM; nwg = nM * nN; G = G_; c = c_; }
    __device__ bool next(int i, Unit& u) const {
        const long L = (long)i * G + c; if (L >= nwg) return false;
        int wgid = (int)L; { const int q = nwg / NXCD, r = nwg % NXCD, xcd = wgid % NXCD, off = wgid / NXCD; wgid = (xcd < r ? xcd * (q + 1) : r * (q + 1) + (xcd - r) * q) + off; }
        const int nig = WGM * nN, gid = wgid / nig, fm = gid * WGM, gsz = (nM - fm) < WGM ? (nM - fm) : WGM;
        u.pm = fm + ((wgid % nig) % gsz); u.pn = (wgid % nig) / gsz; return true;
    }
};

template <class Epi>
__device__ __forceinline__ void gemm_phase(LAS unsigned char* lds, const Gemm g, const StaticOrder& S, const Epi& E) {
    const int tid = tid_(), wid = __builtin_amdgcn_readfirstlane(tid >> 6), lane = tid & 63, wr = wid >> 2, wc = wid & 3, fr = lane & 15, fq = lane >> 4;
    const int K = g.K, nt = K / BK;
    unsigned voffA[2], voffB[2];
#pragma unroll
    for (int i = 0; i < 2; ++i) { int R, C; stage_rc(tid * 16 + i * 8192, R, C); const int Rb = (R & ~31) + perm32(R & 31);
        voffA[i] = (unsigned)(R * K + C) * 2u; voffB[i] = (unsigned)(Rb * K + C) * 2u; }
    const size_t kstep = (size_t)(BK * 2);
    const size_t hstep = (size_t)HALF * K * 2;
    const size_t tstep = 2 * hstep;
    const unsigned ldsw = (unsigned)wid * 1024u;
    const int aoff = lds_byte(wr * 64 + fr, fq * 8), boff = lds_byte(wc * 32 + fr, fq * 8);
#define PG8_SA(b, h) (((b) * 2 + (h)) * HTB)
#define PG8_SB(b, h) ((4 + (b) * 2 + (h)) * HTB)
#define PG8_STAGE(bufoff, gbase, voff) do { _Pragma("unroll") for (int _i = 0; _i < 2; ++_i) \
        __builtin_amdgcn_global_load_lds((const unsigned*)((const char*)(gbase) + (voff)[_i]), (LAS unsigned*)(lds + (bufoff) + ldsw + _i * 8192), 16, 0, 0); } while (0)
#define PG8_LDA(dst, b, h) do { _Pragma("unroll") for (int m = 0; m < 4; ++m) _Pragma("unroll") for (int k = 0; k < 2; ++k) dst[m][k] = *(const LAS bf16x8*)(lds + PG8_SA(b, h) + aoff + m * 2048 + k * 1024); } while (0)
#define PG8_LDB(dst, b, h) do { _Pragma("unroll") for (int n = 0; n < 2; ++n) _Pragma("unroll") for (int k = 0; k < 2; ++k) dst[n][k] = *(const LAS bf16x8*)(lds + PG8_SB(b, h) + boff + n * 2048 + k * 1024); } while (0)
#define PG8_MMA(ai, bj, At, Bt) do { __builtin_amdgcn_s_setprio(1); _Pragma("unroll") for (int m = 0; m < 4; ++m) _Pragma("unroll") for (int n = 0; n < 2; ++n) _Pragma("unroll") for (int k = 0; k < 2; ++k) \
        acc[ai][bj][m][n] = __builtin_amdgcn_mfma_f32_16x16x32_bf16(Bt[n][k], At[m][k], acc[ai][bj][m][n], 0, 0, 0); __builtin_amdgcn_s_setprio(0); } while (0)
#define PG8_WAIT_V(n) asm volatile("s_waitcnt vmcnt(" #n ")" ::: "memory")
#define PG8_WAIT_L(n) asm volatile("s_waitcnt lgkmcnt(" #n ")" ::: "memory")
#define PG8_BAR __builtin_amdgcn_s_barrier()
#define PG8_SCHED __builtin_amdgcn_sched_barrier(0)
    Unit cur, nxt; int ui = 0;
    if (!S.next(0, cur)) return;
    f32x4 acc[2][2][4][2];
#pragma unroll
    for (int a = 0; a < 2; ++a)
#pragma unroll
        for (int b = 0; b < 2; ++b)
#pragma unroll
            for (int m = 0; m < 4; ++m)
#pragma unroll
                for (int n = 0; n < 2; ++n) acc[a][b][m][n] = (f32x4){0.f, 0.f, 0.f, 0.f};
    bf16x8 At[4][2], B0[2][2], B1[2][2];
    float epre[2] = {0.f, 0.f};
    const char* cA = (const char*)g.A + (size_t)cur.pm * tstep; const char* cB = (const char*)g.Bt + (size_t)cur.pn * tstep;
    PG8_STAGE(PG8_SB(0, 0), cB, voffB); PG8_STAGE(PG8_SA(0, 0), cA, voffA); PG8_STAGE(PG8_SB(0, 1), cB + hstep, voffB); PG8_STAGE(PG8_SA(0, 1), cA + hstep, voffA);
    if (wr == 1) PG8_BAR;
    PG8_WAIT_V(4); PG8_BAR;
    PG8_STAGE(PG8_SB(1, 0), cB + kstep, voffB); PG8_STAGE(PG8_SA(1, 0), cA + kstep, voffA); PG8_STAGE(PG8_SB(1, 1), cB + hstep + kstep, voffB);
    PG8_WAIT_V(6); PG8_BAR;
    for (;;) {
        const bool has_next = S.next(ui + 1, nxt);
        const char* nA = has_next ? (const char*)g.A + (size_t)nxt.pm * tstep : cA; const char* nB = has_next ? (const char*)g.Bt + (size_t)nxt.pn * tstep : cB;
        for (int t = 0; t < nt; t += 2) {
            const bool last = (t == nt - 2);
            const char* a1 = cA + (size_t)(t + 1) * kstep;
            const char* a2 = last ? nA : cA + (size_t)(t + 2) * kstep; const char* b2 = last ? nB : cB + (size_t)(t + 2) * kstep;
            const char* a3 = a2 + kstep; const char* b3 = b2 + kstep;
            if (last) E.pre(cur, wr, wc, lane, epre);
            PG8_LDB(B0, 0, 0); PG8_SCHED; PG8_LDA(At, 0, 0); PG8_STAGE(PG8_SA(1, 1), a1 + hstep, voffA);
            PG8_WAIT_L(8); PG8_BAR; PG8_WAIT_L(0); PG8_MMA(0, 0, At, B0); PG8_BAR; PG8_SCHED;
            PG8_LDB(B1, 0, 1); PG8_STAGE(PG8_SB(0, 0), b2, voffB);
            PG8_BAR; PG8_WAIT_L(0); PG8_MMA(0, 1, At, B1); PG8_BAR;
            PG8_LDA(At, 0, 1); PG8_STAGE(PG8_SA(0, 0), a2, voffA);
            PG8_BAR; PG8_WAIT_L(0); PG8_MMA(1, 0, At, B0); PG8_BAR; PG8_SCHED;
            PG8_STAGE(PG8_SB(0, 1), b2 + hstep, voffB);
            PG8_WAIT_V(6); PG8_BAR; PG8_MMA(1, 1, At, B1); PG8_BAR;
            PG8_LDB(B0, 1, 0); PG8_SCHED; PG8_LDA(At, 1, 0); PG8_STAGE(PG8_SA(0, 1), a2 + hstep, voffA);
            PG8_WAIT_L(8); PG8_BAR; PG8_WAIT_L(0); PG8_MMA(0, 0, At, B0); PG8_BAR; PG8_SCHED;
            PG8_LDB(B1, 1, 1); PG8_STAGE(PG8_SB(1, 0), b3, voffB);
            PG8_BAR; PG8_WAIT_L(0); PG8_MMA(0, 1, At, B1); PG8_BAR;
            PG8_LDA(At, 1, 1); PG8_STAGE(PG8_SA(1, 0), a3, voffA);
            PG8_BAR; PG8_WAIT_L(0); PG8_MMA(1, 0, At, B0); PG8_BAR; PG8_SCHED;
            PG8_STAGE(PG8_SB(1, 1), b3 + hstep, voffB);
            PG8_WAIT_V(6); PG8_BAR; PG8_MMA(1, 1, At, B1); PG8_BAR;
        }
        E(acc, cur, wr, wc, fr, fq, epre);
        if (!has_next) break;
#pragma unroll
        for (int a = 0; a < 2; ++a)
#pragma unroll
            for (int b = 0; b < 2; ++b)
#pragma unroll
                for (int m = 0; m < 4; ++m)
#pragma unroll
                    for (int n = 0; n < 2; ++n) acc[a][b][m][n] = (f32x4){0.f, 0.f, 0.f, 0.f};
        cur = nxt; cA = nA; cB = nB; ++ui;
    }
    PG8_WAIT_V(0);
    if (wr == 0) PG8_BAR;
    PG8_BAR;
#undef PG8_SA
#undef PG8_SB
#undef PG8_STAGE
#undef PG8_LDA
#undef PG8_LDB
#undef PG8_MMA
#undef PG8_WAIT_V
#undef PG8_WAIT_L
#undef PG8_BAR
#undef PG8_SCHED
}
}
using pg8::Unit;

typedef f32x4 AccT[2][2][4][2];

struct EpiGT {
    bf16_t* GT; const float* rstd;
    __device__ __forceinline__ void pre(const Unit& u, int wr, int wc, int lane, float (&r)[2]) const { r[0] = rstd[u.pn * 256 + (lane >> 5) * 128 + wc * 32 + (lane & 31)]; }
    __device__ __forceinline__ void operator()(const AccT& acc, const Unit& u, int wr, int wc, int fr, int fq, const float (&epre)[2]) const {
        const int row0 = u.pm * 256 + wr * 64 + fr, tok0 = u.pn * 256 + wc * 32 + 8 * fq;
#pragma unroll
        for (int bj = 0; bj < 2; ++bj) {
            const int tok = tok0 + bj * 128;
            f32x4 r0, r1;
#pragma unroll
            for (int j = 0; j < 4; ++j) { r0[j] = __shfl(epre[0], bj * 32 + 8 * fq + j); r1[j] = __shfl(epre[0], bj * 32 + 8 * fq + 4 + j); }
            bf16_t* base = GT + (size_t)(tok >> 12) * (512 * 4096) + (tok & 4095);
#pragma unroll
            for (int ai = 0; ai < 2; ++ai)
#pragma unroll
                for (int m = 0; m < 4; ++m) {
                    const f32x4 v0 = acc[ai][bj][m][0] * r0, v1 = acc[ai][bj][m][1] * r1;
                    u32x4 o; o[0] = pk2(v0[0], v0[1]); o[1] = pk2(v0[2], v0[3]); o[2] = pk2(v1[0], v1[1]); o[3] = pk2(v1[2], v1[3]);
                    __builtin_nontemporal_store(o, (u32x4*)(base + (size_t)(row0 + ai * 128 + m * 16) * 4096));
                }
        }
    }
};
struct EpiRest {
    bf16_t *Q, *K, *V, *G, *LAF, *LAB; const float *rstd, *b_af, *b_ab;
    __device__ __forceinline__ void pre(const Unit& u, int wr, int wc, int lane, float (&r)[2]) const { const int row = u.pm * 256 + wr * 64 + lane; r[0] = rstd[row]; r[1] = rstd[row + 128]; }
    __device__ __forceinline__ void operator()(const AccT& acc, const Unit& u, int wr, int wc, int fr, int fq, const float (&epre)[2]) const {
        const int row0 = u.pm * 256 + wr * 64 + fr, cl0 = wc * 32 + 8 * fq;
        const int pn = u.pn;
        bf16_t* dst; int ld, coff = 0, mode = 0; const float* bias = nullptr;
        if (pn == 0) { dst = Q; ld = 256; }
        else if (pn == 1) { dst = K; ld = 256; }
        else if (pn < 4) { dst = V; ld = 512; coff = (pn - 2) * 256; }
        else if (pn < 6) { dst = G; ld = 512; coff = (pn - 4) * 256; mode = 1; }
        else if (pn == 6) { dst = LAF; ld = 256; mode = 2; bias = b_af; }
        else { dst = LAB; ld = 256; mode = 2; bias = b_ab; }
#pragma unroll
        for (int bj = 0; bj < 2; ++bj) {
            const int cl = cl0 + bj * 128;
            f32x4 bv0 = (f32x4){0.f, 0.f, 0.f, 0.f}, bv1 = bv0;
            if (mode == 2) { bv0 = *(const f32x4*)(bias + cl); bv1 = *(const f32x4*)(bias + cl + 4); }
#pragma unroll
            for (int ai = 0; ai < 2; ++ai)
#pragma unroll
                for (int m = 0; m < 4; ++m) {
                    const int row = row0 + ai * 128 + m * 16;
                    const float rs = __shfl(epre[ai], m * 16 + fr);
                    float v[8];
#pragma unroll
                    for (int j = 0; j < 4; ++j) { v[j] = acc[ai][bj][m][0][j] * rs; v[4 + j] = acc[ai][bj][m][1][j] * rs; }
                    if (mode == 2) {
#pragma unroll
                        for (int j = 0; j < 8; ++j) v[j] += (j < 4 ? bv0[j] : bv1[j - 4]);
                    }
                    u32x4 o; o[0] = pk2(v[0], v[1]); o[1] = pk2(v[2], v[3]); o[2] = pk2(v[4], v[5]); o[3] = pk2(v[6], v[7]);
                    __builtin_nontemporal_store(o, (u32x4*)(dst + (size_t)row * ld + coff + cl));
                }
        }
    }
};
struct EpiMF {
    bf16_t* MF; float* ssqp;
    __device__ __forceinline__ void pre(const Unit&, int, int, int, float (&)[2]) const {}
    __device__ __forceinline__ void operator()(const AccT& acc, const Unit& u, int wr, int wc, int fr, int fq, const float (&epre)[2]) const {
        const int row0 = u.pm * 256 + wr * 64 + fr, c0 = u.pn * 256 + wc * 32 + 8 * fq;
#pragma unroll
        for (int ai = 0; ai < 2; ++ai)
#pragma unroll
            for (int m = 0; m < 4; ++m) {
                const int row = row0 + ai * 128 + m * 16;
                float ss = 0.f;
#pragma unroll
                for (int bj = 0; bj < 2; ++bj) {
                    const f32x4 v0 = acc[ai][bj][m][0], v1 = acc[ai][bj][m][1];
                    u32x4 o; o[0] = pk2(v0[0], v0[1]); o[1] = pk2(v0[2], v0[3]); o[2] = pk2(v1[0], v1[1]); o[3] = pk2(v1[2], v1[3]);
                    __builtin_nontemporal_store(o, (u32x4*)(MF + (size_t)row * 1024 + c0 + bj * 128));
#pragma unroll
                    for (int j = 0; j < 4; ++j) ss += v0[j] * v0[j] + v1[j] * v1[j];
                }
                ss += __shfl_xor(ss, 16); ss += __shfl_xor(ss, 32);
                if (fq == 0) ssqp[(size_t)row * 16 + u.pn * 4 + wc] = ss;
            }
    }
};
struct EpiGU {
    bf16_t* H; const float* rstd;
    __device__ __forceinline__ void pre(const Unit& u, int wr, int wc, int lane, float (&r)[2]) const { const int row = u.pm * 256 + wr * 64 + lane; r[0] = rstd[row]; r[1] = rstd[row + 128]; }
    __device__ __forceinline__ void operator()(const AccT& acc, const Unit& u, int wr, int wc, int fr, int fq, const float (&epre)[2]) const {
        const int row0 = u.pm * 256 + wr * 64 + fr, c0 = u.pn * 128 + wc * 32 + 8 * fq;
#pragma unroll
        for (int ai = 0; ai < 2; ++ai)
#pragma unroll
            for (int m = 0; m < 4; ++m) {
                const int row = row0 + ai * 128 + m * 16;
                const float rs = __shfl(epre[ai], m * 16 + fr);
                float h[8];
#pragma unroll
                for (int n = 0; n < 2; ++n)
#pragma unroll
                    for (int j = 0; j < 4; ++j) { const float gg = acc[ai][0][m][n][j] * rs, uu = acc[ai][1][m][n][j] * rs; h[n * 4 + j] = gg * uu * __builtin_amdgcn_rcpf(1.f + __builtin_amdgcn_exp2f(gg * -1.4426950408889634f)); }
                u32x4 o; o[0] = pk2(h[0], h[1]); o[1] = pk2(h[2], h[3]); o[2] = pk2(h[4], h[5]); o[3] = pk2(h[6], h[7]);
                __builtin_nontemporal_store(o, (u32x4*)(H + (size_t)row * DFF + c0));
            }
    }
};

#define MFMA16(a, b, c) __builtin_amdgcn_mfma_f32_16x16x32_bf16((a), (b), (c), 0, 0, 0)
struct TrDesc { const float* src; bf16_t* dst; const float* gain; int ld, ldd; float scale; int mir; };
__device__ __forceinline__ void tr_desc(const Params& p, int it, TrDesc& d) {
    const int l = it / 2752; int t = it % 2752;
    bf16_t* W = p.Wt + (size_t)l * W_LAYER;
    d.mir = 0;
    if (t < 384) {
        const int ct = t >> 4, kt = t & 15, c0 = 512 + ct * 64;
        d.src = p.w_in + (size_t)l * DM * INC + (size_t)(kt * 64) * INC + c0; d.ld = INC; d.dst = W + W_IN + (size_t)(1024 + ct * 64) * 1024 + kt * 64; d.ldd = 1024; d.gain = p.norm_mix_pre + l * DM + kt * 64; d.scale = c0 < 768 ? 0.125f : 1.f;
    } else if (t < 640) {
        t -= 384; const int ct = t >> 4, kt = t & 15;
        d.src = p.w_out + (size_t)l * DM * DM + (size_t)(kt * 64) * DM + ct * 64; d.ld = DM; d.dst = W + W_OUT + (size_t)(ct * 64) * 1024 + kt * 64; d.ldd = 1024; d.gain = nullptr; d.scale = 1.f;
        if (kt < 8 && (kt & 1)) { d.mir = 1; d.src = p.w_out + (size_t)l * DM * DM + (size_t)((kt >> 1) * 128) * DM + ct * 64; }
    } else if (t < 2048) {
        t -= 640; const int up = t >= 704; if (up) t -= 704; const int ct = t >> 4, kt = t & 15, c0 = ct * 64;
        d.src = (up ? p.w_u : p.w_g) + (size_t)l * DM * DFF + (size_t)(kt * 64) * DFF + c0; d.ld = DFF; d.dst = W + W_GU + (size_t)(256 * (c0 >> 7) + (c0 & 127) + (up ? 128 : 0)) * 1024 + kt * 64; d.ldd = 1024; d.gain = p.norm_ffn_pre + l * DM + kt * 64; d.scale = 1.f;
    } else {
        t -= 2048; const int ct = t / 44, kt = t % 44;
        d.src = p.w_d + (size_t)l * DFF * DM + (size_t)(kt * 64) * DM + ct * 64; d.ld = DM; d.dst = W + W_D + (size_t)(ct * 64) * DFF + kt * 64; d.ldd = DFF; d.gain = nullptr; d.scale = 1.f;
    }
}
struct TrRegs { f32x4 v[2]; float g[2]; };
__device__ __forceinline__ void tr_load(const TrDesc& d, int tid, TrRegs& r) {
#pragma unroll
    for (int i = 0; i < 2; ++i) { const int idx = tid + i * 512, rr = idx >> 4, c4 = (idx & 15) * 4;
        const int srow = d.mir ? (rr == 0 ? 64 : 128 - rr) : rr;
        r.v[i] = *(const f32x4*)(d.src + (size_t)srow * d.ld + c4);
        r.g[i] = d.gain ? d.gain[rr] * d.scale : d.scale; }
}

__device__ void phase_prep(const Params& p, LAS unsigned char* lds, int bid, int nblk) {
    const int tid = tid_();
    LAS float* tile = (LAS float*)lds;
    if (bid < NLAYER * 2752) {
        TrDesc d; TrRegs r; tr_desc(p, bid, d); tr_load(d, tid, r);
        int buf = 0;
        for (int it = bid; it < NLAYER * 2752; it += nblk) {
            LAS float* tl = tile + buf * (64 * 65);
#pragma unroll
            for (int i = 0; i < 2; ++i) { const int idx = tid + i * 512, rr = idx >> 4, c4 = (idx & 15) * 4; const float g = r.g[i];
                tl[rr * 65 + c4 + 0] = r.v[i][0] * g; tl[rr * 65 + c4 + 1] = r.v[i][1] * g; tl[rr * 65 + c4 + 2] = r.v[i][2] * g; tl[rr * 65 + c4 + 3] = r.v[i][3] * g; }
            __syncthreads();
            const TrDesc dc = d;
            if (it + nblk < NLAYER * 2752) { tr_desc(p, it + nblk, d); tr_load(d, tid, r); }
            { const int n = tid >> 3, k8 = (tid & 7) * 8; u32x4 o;
#pragma unroll
              for (int e = 0; e < 4; ++e) o[e] = pk2(tl[(k8 + 2 * e) * 65 + n], tl[(k8 + 2 * e + 1) * 65 + n]);
              *(u32x4*)(dc.dst + (size_t)n * dc.ldd + k8) = o; }
            buf ^= 1;
        }
        __syncthreads();
    }
    {
        const int lane = tid & 63, wid = tid >> 6, fr = lane & 15, fq = lane >> 4;
        for (int it = bid; it < NLAYER * 4 * 16; it += nblk) {
            const int l = it >> 6, g = (it >> 4) & 3, k0 = (it & 15) * 64;
            const float* src = p.w_in + (size_t)l * DM * INC + g * 128;
            bf16_t* W = p.Wt + (size_t)l * W_LAYER + W_IN;
            const int rl = wid * 16 + fr, cc = rl <= 64 ? rl : rl - 64; const bool is_sin = rl >= 65;
            bf16x8 Bt[4];
#pragma unroll
            for (int ks = 0; ks < 4; ++ks) { float t[8];
#pragma unroll
                for (int e = 0; e < 8; ++e) { const int c = ks * 32 + fq * 8 + e; const float a = (float)((c * cc) & 127) * (1.f / 128.f);
                    t[e] = (is_sin ? __builtin_amdgcn_sinf(a) : __builtin_amdgcn_cosf(a)) * 0.08838834764831845f; }
                u32x4 o; o[0] = pk2(t[0], t[1]); o[1] = pk2(t[2], t[3]); o[2] = pk2(t[4], t[5]); o[3] = pk2(t[6], t[7]); Bt[ks] = __builtin_bit_cast(bf16x8, o); }
#pragma unroll
            for (int mb = 0; mb < 4; ++mb) {
                bf16x8 Af[4];
#pragma unroll
                for (int ks = 0; ks < 4; ++ks) { const float* pa = src + (size_t)(k0 + mb * 16 + fr) * INC + ks * 32 + fq * 8;
                    const f32x4 a0 = *(const f32x4*)pa, a1 = *(const f32x4*)(pa + 4);
                    u32x4 o; o[0] = pk2(a0[0], a0[1]); o[1] = pk2(a0[2], a0[3]); o[2] = pk2(a1[0], a1[1]); o[3] = pk2(a1[2], a1[3]); Af[ks] = __builtin_bit_cast(bf16x8, o); }
                const f32x4 gn = *(const f32x4*)(p.norm_mix_pre + l * DM + k0 + mb * 16 + 4 * fq);
                f32x4 acc = (f32x4){0.f, 0.f, 0.f, 0.f};
#pragma unroll
                for (int ks = 0; ks < 4; ++ks) acc = MFMA16(Af[ks], Bt[ks], acc);
                u32x2 o; o[0] = pk2(acc[0] * gn[0], acc[1] * gn[1]); o[1] = pk2(acc[2] * gn[2], acc[3] * gn[3]);
                *(u32x2*)(W + (size_t)(g * 128 + rl) * 1024 + k0 + mb * 16 + 4 * fq) = o;
            }
        }
    }
    for (int it = bid; it < NLAYER * 2 * 2 * 32; it += nblk) {
        const int jc = it & 31, kh = (it >> 5) & 1, fb = (it >> 6) & 1, l = it >> 7, k = kh * 512 + tid;
        const float* wr_ = p.w_in + (size_t)l * DM * INC + (size_t)k * INC + 2048 + fb * 16;
        float w[16];
#pragma unroll
        for (int r4 = 0; r4 < 4; ++r4) { const f32x4 v = *(const f32x4*)(wr_ + r4 * 4); w[r4 * 4] = v[0]; w[r4 * 4 + 1] = v[1]; w[r4 * 4 + 2] = v[2]; w[r4 * 4 + 3] = v[3]; }
        const float gain = p.norm_mix_pre[l * DM + k];
        const float* wa = (fb ? p.w_ab : p.w_af) + (size_t)l * 16 * 256 + jc * 8;
        bf16_t* dst = p.Wt + (size_t)l * W_LAYER + W_IN + (size_t)(2560 + fb * 256 + jc * 8) * 1024 + k;
#pragma unroll
        for (int j = 0; j < 8; ++j) { float sacc = 0.f;
#pragma unroll
            for (int r = 0; r < 16; ++r) sacc += w[r] * wa[r * 256 + j];
            dst[(size_t)j * 1024] = f2bf(sacc * gain); }
    }
    for (int id = bid * NTHREADS + tid; id < 3 * 8192; id += nblk * NTHREADS) {
        const int t = id >> 13, k = (id >> 7) & 63, K = id & 127, reim = K >> 6, n = K & 63;
        const float a = (float)((k * n) & 63) * (1.f / 64.f), c = __builtin_amdgcn_cosf(a) * 0.125f, sn = __builtin_amdgcn_sinf(a) * 0.125f;
        const float v = t == 0 ? (reim ? -sn : c) : (t == 1 ? (reim ? -c : -sn) : (reim ? sn : c));
        p.FT[id] = f2bf(v);
    }
    {
        const int lane = tid & 63, wid = tid >> 6;
        int row = bid * 8 + wid;
        f32x4 v[4];
        if (row < NTOK) {
#pragma unroll
            for (int i = 0; i < 4; ++i) v[i] = *(const f32x4*)(p.x + (size_t)row * DM + i * 256 + lane * 4); }
        for (; row < NTOK; row += nblk * 8) {
            f32x4 vn[4]; const int rn = row + nblk * 8 < NTOK ? row + nblk * 8 : row;
#pragma unroll
            for (int i = 0; i < 4; ++i) vn[i] = *(const f32x4*)(p.x + (size_t)rn * DM + i * 256 + lane * 4);
            float ss = 0.f;
#pragma unroll
            for (int i = 0; i < 4; ++i) ss += v[i][0] * v[i][0] + v[i][1] * v[i][1] + v[i][2] * v[i][2] + v[i][3] * v[i][3];
#pragma unroll
            for (int o = 32; o > 0; o >>= 1) ss += __shfl_xor(ss, o);
#pragma unroll
            for (int i = 0; i < 4; ++i) { u32x2 o; o[0] = pk2(v[i][0], v[i][1]); o[1] = pk2(v[i][2], v[i][3]); *(u32x2*)(p.XB + (size_t)row * DM + i * 256 + lane * 4) = o; }
#pragma unroll
            for (int i = 0; i < 4; ++i) v[i] = vn[i];
            if (lane == 0) p.rstd[row] = rsqrtf(ss * (1.f / 1024.f) + 1e-6f);
        }
    }
}

struct RowRegs { u32x4 mv[2], xb[2]; f32x4 xf[4], s[4]; };
template <bool XF32>
__device__ __forceinline__ void row_load(const Params& p, const float* xin_f32, int row, int lane, RowRegs& r) {
#pragma unroll
    for (int j = 0; j < 4; ++j) r.s[j] = *(const f32x4*)(p.ssqp + (size_t)row * 16 + 4 * j);
#pragma unroll
    for (int i = 0; i < 2; ++i) { const int c = i * 512 + lane * 8;
        r.mv[i] = *(const u32x4*)(p.MF + (size_t)row * DM + c);
        if (XF32) { r.xf[2 * i] = *(const f32x4*)(xin_f32 + (size_t)row * DM + c); r.xf[2 * i + 1] = *(const f32x4*)(xin_f32 + (size_t)row * DM + c + 4); }
        else r.xb[i] = *(const u32x4*)(p.XB + (size_t)row * DM + c); }
}
template <bool XF32>
__device__ __forceinline__ void phase_row_t(const Params& p, const float* xin_f32, const float* wpost, bool last, int bid, int nblk) {
    const int tid = tid_(), lane = tid & 63, wid = tid >> 6;
    f32x4 wv[2][2];
#pragma unroll
    for (int i = 0; i < 2; ++i) { wv[i][0] = *(const f32x4*)(wpost + i * 512 + lane * 8); wv[i][1] = *(const f32x4*)(wpost + i * 512 + lane * 8 + 4); }
    int row = bid * 8 + wid;
    if (row >= NTOK) return;
    RowRegs cur; row_load<XF32>(p, xin_f32, row, lane, cur);
    for (; row < NTOK; row += nblk * 8) {
        RowRegs nxt; row_load<XF32>(p, xin_f32, row + nblk * 8 < NTOK ? row + nblk * 8 : row, lane, nxt);
        float sm = 0.f;
#pragma unroll
        for (int j = 0; j < 4; ++j) sm += cur.s[0][j] + cur.s[1][j] + cur.s[2][j] + cur.s[3][j];
        const float rm = rsqrtf(sm * (1.f / 1024.f) + 1e-6f);
        float ss = 0.f; float v[2][8];
#pragma unroll
        for (int i = 0; i < 2; ++i) {
            const u32x4 mv = cur.mv[i]; const f32x4 w0 = wv[i][0], w1 = wv[i][1];
            float xv[8];
            if (XF32) {
#pragma unroll
                for (int j = 0; j < 4; ++j) { xv[j] = cur.xf[2 * i][j]; xv[4 + j] = cur.xf[2 * i + 1][j]; } }
            else {
#pragma unroll
                for (int j = 0; j < 4; ++j) { xv[2 * j] = bflo(cur.xb[i][j]); xv[2 * j + 1] = bfhi(cur.xb[i][j]); } }
#pragma unroll
            for (int j = 0; j < 4; ++j) { v[i][2 * j] = xv[2 * j] + bflo(mv[j]) * rm * (j < 2 ? w0[2 * j] : w1[2 * j - 4]); v[i][2 * j + 1] = xv[2 * j + 1] + bfhi(mv[j]) * rm * (j < 2 ? w0[2 * j + 1] : w1[2 * j - 3]); }
#pragma unroll
            for (int j = 0; j < 8; ++j) ss += v[i][j] * v[i][j]; }
#pragma unroll
        for (int o = 32; o > 0; o >>= 1) ss += __shfl_xor(ss, o);
#pragma unroll
        for (int i = 0; i < 2; ++i) { const int c = i * 512 + lane * 8;
            if (last) { *(f32x4*)(p.out + (size_t)row * DM + c) = (f32x4){v[i][0], v[i][1], v[i][2], v[i][3]}; *(f32x4*)(p.out + (size_t)row * DM + c + 4) = (f32x4){v[i][4], v[i][5], v[i][6], v[i][7]}; }
            else { u32x4 o; o[0] = pk2(v[i][0], v[i][1]); o[1] = pk2(v[i][2], v[i][3]); o[2] = pk2(v[i][4], v[i][5]); o[3] = pk2(v[i][6], v[i][7]); *(u32x4*)(p.XB + (size_t)row * DM + c) = o; } }
        if (lane == 0 && !last) p.rstd[row] = rsqrtf(ss * (1.f / 1024.f) + 1e-6f);
        cur = nxt;
    }
}
__device__ void phase_row(const Params& p, const float* xin_f32, const float* wpost, bool last, int bid, int nblk) {
    if (xin_f32) phase_row_t<true>(p, xin_f32, wpost, last, bid, nblk); else phase_row_t<false>(p, nullptr, wpost, last, bid, nblk);
}

typedef const LAS bf16x8* lbp;

__device__ __forceinline__ float logsig16(float z) { return (fminf(z, 0.f) - __logf(1.f + __expf(-fabsf(z)))) * 0.0625f; }
__device__ __forceinline__ float silu_f(float g) { return g * __builtin_amdgcn_rcpf(1.f + __builtin_amdgcn_exp2f(g * -1.4426950408889634f)); }
struct GlaRegs { u32x4 rf, rb, va, vc, rq, rk, g0, g1; };
template <bool WITH_QG>
__device__ __forceinline__ void gla_issue(const Params& p, int tile, int tid, GlaRegs& r) {
    const int bh = tile >> 6, n = tile & 63, b = bh >> 2, h = bh & 3;
    const size_t tok0 = (size_t)b * 4096 + n * 64;
    const int j = tid >> 3, d0 = (tid & 7) * 8, v0 = (tid & 7) * 16;
    r.rf = *(const u32x4*)(p.LAF + (tok0 + j) * 256 + h * 64 + d0); r.rb = *(const u32x4*)(p.LAB + (tok0 + j) * 256 + h * 64 + d0);
    const bf16_t* pv = p.V + (tok0 + j) * 512 + h * 128 + v0;
    r.va = *(const u32x4*)pv; r.vc = *(const u32x4*)(pv + 8);
    r.rk = *(const u32x4*)(p.K + (tok0 + j) * 256 + h * 64 + d0);
    if (WITH_QG) { r.rq = *(const u32x4*)(p.Q + (tok0 + j) * 256 + h * 64 + d0);
        const bf16_t* pg = p.G + (tok0 + j) * 512 + h * 128 + v0; r.g0 = *(const u32x4*)pg; r.g1 = *(const u32x4*)(pg + 8); }
}
__device__ __forceinline__ void gla_load_scan(const GlaRegs& r, int tid, LAS float* cumf, LAS float* cumb, LAS float* segs, LAS bf16_t* vT) {
    { const int j = tid >> 3, d0 = (tid & 7) * 8;
      const u32x4 rf = r.rf, rb = r.rb;
#pragma unroll
      for (int e = 0; e < 4; ++e) { cumf[j * 65 + d0 + 2 * e] = logsig16(bflo(rf[e])); cumf[j * 65 + d0 + 2 * e + 1] = logsig16(bfhi(rf[e])); cumb[j * 65 + d0 + 2 * e] = logsig16(bflo(rb[e])); cumb[j * 65 + d0 + 2 * e + 1] = logsig16(bfhi(rb[e])); }
      const int v0 = (tid & 7) * 16;
      const u32x4 a = r.va, c = r.vc;
#pragma unroll
      for (int e = 0; e < 4; ++e) { vT[(v0 + 2 * e) * 72 + j] = (bf16_t)(a[e] & 0xffffu); vT[(v0 + 2 * e + 1) * 72 + j] = (bf16_t)(a[e] >> 16);
                                    vT[(v0 + 8 + 2 * e) * 72 + j] = (bf16_t)(c[e] & 0xffffu); vT[(v0 + 8 + 2 * e + 1) * 72 + j] = (bf16_t)(c[e] >> 16); }
    }
    __syncthreads();
    const int dir = tid >> 8, seg = (tid >> 6) & 3, d = tid & 63;
    LAS float* c = dir ? cumb : cumf;
    float c16[16];
#pragma unroll
    for (int jj = 0; jj < 16; ++jj) c16[jj] = c[(seg * 16 + jj) * 65 + d];
    if (!dir) {
#pragma unroll
        for (int jj = 1; jj < 16; ++jj) c16[jj] += c16[jj - 1];
        segs[seg * 64 + d] = c16[15];
    } else {
#pragma unroll
        for (int jj = 14; jj >= 0; --jj) c16[jj] += c16[jj + 1];
        segs[(4 + seg) * 64 + d] = c16[0];
    }
    __syncthreads();
    { float off = 0.f;
      if (!dir) { for (int s = 0; s < seg; ++s) off += segs[s * 64 + d]; }
      else { for (int s = 3; s > seg; --s) off += segs[(4 + s) * 64 + d]; }
#pragma unroll
      for (int jj = 0; jj < 16; ++jj) c[(seg * 16 + jj) * 65 + d] = c16[jj] + off; }
    __syncthreads();
}

__device__ void phase_gla_state(const Params& p, LAS unsigned char* lds, int bid, int nblk) {
    const int tid = tid_(), lane = tid & 63, wid = tid >> 6, fr = lane & 15, fq = lane >> 4;
    LAS float* cumf = (LAS float*)lds; LAS float* cumb = cumf + 64 * 65; LAS float* segs = cumb + 64 * 65;
    LAS bf16_t* kTf = (LAS bf16_t*)(lds + 36864); LAS bf16_t* kTb = kTf + 64 * 72; LAS bf16_t* vT = (LAS bf16_t*)(lds + 82944);
    GlaRegs cur; gla_issue<false>(p, bid < 2048 ? bid : 0, tid, cur);
    for (int tile = bid; tile < 2048; tile += nblk) {
        GlaRegs nxt; gla_issue<false>(p, tile + nblk < 2048 ? tile + nblk : tile, tid, nxt);
        gla_load_scan(cur, tid, cumf, cumb, segs, vT);
        { const int j = tid >> 3, d0 = (tid & 7) * 8;
          const u32x4 rk = cur.rk;
#pragma unroll
          for (int e = 0; e < 8; ++e) { const int d = d0 + e; const float kv = (e & 1) ? bfhi(rk[e >> 1]) : bflo(rk[e >> 1]);
              kTf[d * 72 + j] = f2bf(kv * __expf(cumf[63 * 65 + d] - cumf[j * 65 + d]));
              kTb[d * 72 + j] = f2bf(kv * __expf(cumb[d] - cumb[j * 65 + d])); }
          if (tid < 64) { p.decf[(size_t)tile * 64 + tid] = __expf(cumf[63 * 65 + tid]); p.decb[(size_t)tile * 64 + tid] = __expf(cumb[tid]); }
        }
        __syncthreads();
        { const int dir = wid >> 2, rb = wid & 3;
          LAS bf16_t* kT = dir ? kTb : kTf; bf16_t* CS = (dir ? p.CSB : p.CSF) + (size_t)tile * 8192;
          bf16x8 a[2];
#pragma unroll
          for (int s = 0; s < 2; ++s) a[s] = *(lbp)(kT + (rb * 16 + fr) * 72 + s * 32 + fq * 8);
#pragma unroll
          for (int cb = 0; cb < 8; ++cb) { f32x4 c = (f32x4){0.f, 0.f, 0.f, 0.f};
#pragma unroll
              for (int s = 0; s < 2; ++s) c = MFMA16(a[s], *(lbp)(vT + (cb * 16 + fr) * 72 + s * 32 + fq * 8), c);
              u32x2 o; o[0] = pk2(c[0], c[1]); o[1] = pk2(c[2], c[3]);
              *(u32x2*)(CS + (size_t)(cb * 16 + fr) * 64 + rb * 16 + fq * 4) = o; }
        }
        __syncthreads();
        cur = nxt;
    }
}

__device__ void phase_gla_scan(const Params& p, int bid, int nblk) {
    for (int id = bid * NTHREADS + tid_(); id < 2 * 32 * 2048; id += nblk * NTHREADS) {
        const int dir = id >> 16, bh = (id >> 11) & 31, e = (id & 2047) * 4, d = e & 63;
        bf16_t* cs = (dir ? p.CSB : p.CSF) + (size_t)bh * 64 * 8192 + e;
        const float* dec = (dir ? p.decb : p.decf) + (size_t)bh * 64 * 64 + d;
        f32x4 st = (f32x4){0.f, 0.f, 0.f, 0.f};
        for (int n0 = 0; n0 < 64; n0 += 8) {
            u32x2 c[8]; f32x4 dc[8];
#pragma unroll
            for (int i = 0; i < 8; ++i) { const int n = dir ? 63 - (n0 + i) : n0 + i; c[i] = *(const u32x2*)(cs + (size_t)n * 8192); dc[i] = *(const f32x4*)(dec + n * 64); }
#pragma unroll
            for (int i = 0; i < 8; ++i) { const int n = dir ? 63 - (n0 + i) : n0 + i;
                u32x2 o; o[0] = pk2(st[0], st[1]); o[1] = pk2(st[2], st[3]); *(u32x2*)(cs + (size_t)n * 8192) = o;
                st[0] = st[0] * dc[i][0] + bflo(c[i][0]); st[1] = st[1] * dc[i][1] + bfhi(c[i][0]); st[2] = st[2] * dc[i][2] + bflo(c[i][1]); st[3] = st[3] * dc[i][3] + bfhi(c[i][1]); }
        }
    }
}

__device__ void phase_gla_out(const Params& p, int layer, LAS unsigned char* lds, int bid, int nblk) {
    const int tid = tid_(), lane = tid & 63, wid = tid >> 6, fr = lane & 15, fq = lane >> 4;
    LAS float* cumf = (LAS float*)lds; LAS float* cumb = cumf + 64 * 65; LAS float* segs = cumb + 64 * 65; LAS float* o_l = (LAS float*)lds;
    LAS bf16_t* qef = (LAS bf16_t*)(lds + 36864); LAS bf16_t* kef = qef + 64 * 72; LAS bf16_t* qeb = kef + 64 * 72; LAS bf16_t* keb = qeb + 64 * 72; LAS bf16_t* att = keb + 64 * 72;
    LAS bf16_t* vT = (LAS bf16_t*)(lds + 82944);
    bf16_t* MIX = p.MIX;
    GlaRegs cur; gla_issue<true>(p, bid < 2048 ? bid : 0, tid, cur);
    for (int tile = bid; tile < 2048; tile += nblk) {
        const int bh = tile >> 6, n = tile & 63, b = bh >> 2, h = bh & 3;
        const size_t tok0 = (size_t)b * 4096 + n * 64;
        const int rb = wid & 3;
        bf16x8 pfr[4][2], pbr[4][2];
        { const bf16_t* pf = p.CSF + (size_t)tile * 8192; const bf16_t* pb = p.CSB + (size_t)tile * 8192;
#pragma unroll
          for (int cb = 0; cb < 4; ++cb)
#pragma unroll
              for (int s = 0; s < 2; ++s) { const int vv = (wid >> 2) * 64 + cb * 16 + fr;
                  pfr[cb][s] = *(const bf16x8*)(pf + (size_t)vv * 64 + s * 32 + fq * 8); pbr[cb][s] = *(const bf16x8*)(pb + (size_t)vv * 64 + s * 32 + fq * 8); } }
        GlaRegs nxt; gla_issue<true>(p, tile + nblk < 2048 ? tile + nblk : tile, tid, nxt);
        gla_load_scan(cur, tid, cumf, cumb, segs, vT);
        { const int j = tid >> 3, d0 = (tid & 7) * 8;
          const u32x4 rq = cur.rq, rk = cur.rk;
          u32x4 oqf, okf, oqb, okb;
#pragma unroll
          for (int e = 0; e < 4; ++e) {
              const float cf0 = cumf[j * 65 + d0 + 2 * e], cf1 = cumf[j * 65 + d0 + 2 * e + 1], cb0 = cumb[j * 65 + d0 + 2 * e], cb1 = cumb[j * 65 + d0 + 2 * e + 1];
              const float q0 = bflo(rq[e]), q1 = bfhi(rq[e]), k0 = bflo(rk[e]), k1 = bfhi(rk[e]);
              oqf[e] = pk2(q0 * __expf(cf0), q1 * __expf(cf1)); okf[e] = pk2(k0 * __expf(-cf0), k1 * __expf(-cf1));
              oqb[e] = pk2(q0 * __expf(cb0), q1 * __expf(cb1)); okb[e] = pk2(k0 * __expf(-cb0), k1 * __expf(-cb1)); }
          *(LAS u32x4*)(qef + j * 72 + d0) = oqf; *(LAS u32x4*)(kef + j * 72 + d0) = okf; *(LAS u32x4*)(qeb + j * 72 + d0) = oqb; *(LAS u32x4*)(keb + j * 72 + d0) = okb;
        }
        __syncthreads();
        bf16x8 aqf[2], aqb[2];
#pragma unroll
        for (int s = 0; s < 2; ++s) { aqf[s] = *(lbp)(qef + (rb * 16 + fr) * 72 + s * 32 + fq * 8); aqb[s] = *(lbp)(qeb + (rb * 16 + fr) * 72 + s * 32 + fq * 8); }
#pragma unroll
        for (int jj = 0; jj < 2; ++jj) { const int bj = (wid >> 2) * 2 + jj;
            f32x4 cf = (f32x4){0.f, 0.f, 0.f, 0.f}, cbk = cf;
#pragma unroll
            for (int s = 0; s < 2; ++s) { cf = MFMA16(aqf[s], *(lbp)(kef + (bj * 16 + fr) * 72 + s * 32 + fq * 8), cf); cbk = MFMA16(aqb[s], *(lbp)(keb + (bj * 16 + fr) * 72 + s * 32 + fq * 8), cbk); }
#pragma unroll
            for (int r = 0; r < 4; ++r) { const int i = rb * 16 + fq * 4 + r, j = bj * 16 + fr;
                const float val = j < i ? cf[r] : (j > i ? cbk[r] : cf[r] + cbk[r]); att[i * 72 + j] = f2bf(val); } }
        __syncthreads();
        { const int chh = wid >> 2;
          bf16x8 aat[2];
#pragma unroll
          for (int s = 0; s < 2; ++s) aat[s] = *(lbp)(att + (rb * 16 + fr) * 72 + s * 32 + fq * 8);
#pragma unroll
          for (int cb = 0; cb < 4; ++cb) { const int vvb = chh * 64 + cb * 16; f32x4 a = (f32x4){0.f, 0.f, 0.f, 0.f};
#pragma unroll
              for (int s = 0; s < 2; ++s) a = MFMA16(aat[s], *(lbp)(vT + (vvb + fr) * 72 + s * 32 + fq * 8), a);
#pragma unroll
              for (int s = 0; s < 2; ++s) a = MFMA16(aqf[s], pfr[cb][s], a);
#pragma unroll
              for (int s = 0; s < 2; ++s) a = MFMA16(aqb[s], pbr[cb][s], a);
#pragma unroll
              for (int r = 0; r < 4; ++r) o_l[(rb * 16 + fq * 4 + r) * 132 + vvb + fr] = a[r]; }
        }
        __syncthreads();
        { const int i = tid >> 3, seg = tid & 7; float v[16]; float ss = 0.f;
#pragma unroll
          for (int e4 = 0; e4 < 4; ++e4) { const f32x4 t = *(const LAS f32x4*)(o_l + i * 132 + seg * 16 + e4 * 4);
#pragma unroll
              for (int e = 0; e < 4; ++e) { v[e4 * 4 + e] = t[e]; ss += t[e] * t[e]; } }
          ss += __shfl_xor(ss, 1); ss += __shfl_xor(ss, 2); ss += __shfl_xor(ss, 4);
          const float rs = rsqrtf(ss * (1.f / 128.f) + 1e-6f);
          const u32x4 g0 = cur.g0, g1 = cur.g1;
          const float* wn = p.onorm + layer * 128 + seg * 16;
          u32x4 o0, o1;
#pragma unroll
          for (int e = 0; e < 4; ++e) {
              o0[e] = pk2(v[2 * e] * rs * wn[2 * e] * silu_f(bflo(g0[e])), v[2 * e + 1] * rs * wn[2 * e + 1] * silu_f(bfhi(g0[e])));
              o1[e] = pk2(v[8 + 2 * e] * rs * wn[8 + 2 * e] * silu_f(bflo(g1[e])), v[8 + 2 * e + 1] * rs * wn[8 + 2 * e + 1] * silu_f(bfhi(g1[e]))); }
          bf16_t* po = MIX + (tok0 + i) * 1024 + 512 + h * 128 + seg * 16;
          *(u32x4*)po = o0; *(u32x4*)(po + 8) = o1;
        }
        __syncthreads();
        cur = nxt;
    }
}

__device__ __forceinline__ int zt_off(int reim, int n2, int n1) { return reim * 4096 + n2 * 64 + ((((n1 >> 3) ^ n2 ^ (n2 >> 3)) & 7) << 3) + (n1 & 7); }
__device__ __forceinline__ int bl_off(int k1, int K) { return k1 * 128 + ((((K >> 3) ^ k1) & 15) << 3) + (K & 7); }
#define CFR(kb, ks) (*(lbp)(tab + ((kb) * 16 + fr) * 64 + ((((ks) * 4 + fq) ^ ((fr >> 1) & 7)) << 3)))
#define SFR(kb, ks) (*(lbp)(tab + 4096 + ((kb) * 16 + fr) * 64 + ((((ks) * 4 + fq) ^ ((fr >> 1) & 7)) << 3)))
#define NEG8(x) __builtin_bit_cast(bf16x8, __builtin_bit_cast(u32x4, (x)) ^ (u32x4){0x80008000u, 0x80008000u, 0x80008000u, 0x80008000u})
__device__ __forceinline__ void fft_wave(const bf16_t* cosrow, const bf16_t* sinrow, bool szero, LAS bf16_t* R, LAS bf16_t* tab, int lane, f32x4 (&Y)[4][4]) {
    const int fr = lane & 15, fq = lane >> 4;
#pragma unroll
    for (int reim = 0; reim < 2; ++reim) {
        const bf16_t* src = reim ? sinrow : cosrow;
#pragma unroll
        for (int it = 0; it < 8; ++it) { const int q = it * 64 + lane, n1 = q >> 3, n20 = (q & 7) * 8;
            u32x4 v = *(const u32x4*)(src + q * 8);
            if (reim && szero) v = (u32x4){0u, 0u, 0u, 0u};
#pragma unroll
            for (int e = 0; e < 4; ++e) { R[zt_off(reim, n20 + 2 * e, n1)] = (bf16_t)(v[e] & 0xffffu); R[zt_off(reim, n20 + 2 * e + 1, n1)] = (bf16_t)(v[e] >> 16); } } }
    bf16x8 Bz[4][4];
#pragma unroll
    for (int n2b = 0; n2b < 4; ++n2b)
#pragma unroll
        for (int ks = 0; ks < 4; ++ks) Bz[n2b][ks] = *(lbp)(R + zt_off(ks >> 1, n2b * 16 + fr, (ks & 1) * 32 + fq * 8));
#pragma unroll
    for (int k1b = 0; k1b < 4; ++k1b) {
        bf16x8 Ar[4], Ai[4];
        Ar[0] = CFR(k1b, 0); Ar[1] = CFR(k1b, 1); Ar[2] = NEG8(SFR(k1b, 0)); Ar[3] = NEG8(SFR(k1b, 1));
        Ai[0] = Ar[2]; Ai[1] = Ar[3]; Ai[2] = NEG8(Ar[0]); Ai[3] = NEG8(Ar[1]);
#pragma unroll
        for (int n2b = 0; n2b < 4; ++n2b) {
            f32x4 aR = (f32x4){0.f, 0.f, 0.f, 0.f}, aI = aR;
#pragma unroll
            for (int ks = 0; ks < 4; ++ks) { aR = MFMA16(Ar[ks], Bz[n2b][ks], aR); aI = MFMA16(Ai[ks], Bz[n2b][ks], aI); }
#pragma unroll
            for (int j = 0; j < 4; ++j) { const int k1 = k1b * 16 + 4 * fq + j, n2 = n2b * 16 + fr;
                const float ang = (float)((k1 * n2) & 4095) * (1.f / 4096.f), tc = __builtin_amdgcn_cosf(ang), ts = __builtin_amdgcn_sinf(ang);
                R[bl_off(k1, n2)] = f2bf(aR[j] * tc + aI[j] * ts); R[bl_off(k1, 64 + n2)] = f2bf(aI[j] * tc - aR[j] * ts); }
        }
    }
#pragma unroll
    for (int k2b = 0; k2b < 4; ++k2b) {
        bf16x8 Tb[4];
        Tb[0] = CFR(k2b, 0); Tb[1] = CFR(k2b, 1); Tb[2] = SFR(k2b, 0); Tb[3] = SFR(k2b, 1);
#pragma unroll
        for (int k1b = 0; k1b < 4; ++k1b) { f32x4 a = (f32x4){0.f, 0.f, 0.f, 0.f};
#pragma unroll
            for (int ks = 0; ks < 4; ++ks) a = MFMA16(*(lbp)(R + bl_off(k1b * 16 + fr, ks * 32 + fq * 8)), Tb[ks], a);
            Y[k1b][k2b] = a; }
    }
}
__device__ __forceinline__ void fft_put(LAS bf16_t* plane, int lane, const f32x4 (&Y)[4][4]) {
    const int fr = lane & 15, fq = lane >> 4;
#pragma unroll
    for (int k1b = 0; k1b < 4; ++k1b)
#pragma unroll
        for (int k2b = 0; k2b < 4; ++k2b)
#pragma unroll
            for (int j = 0; j < 4; ++j) plane[(k1b * 16 + 4 * fq + j) * 68 + k2b * 16 + fr] = f2bf(Y[k1b][k2b][j]);
}
__device__ void phase_fft(const Params& p, LAS unsigned char* lds, int bid, int nblk) {
    const int wid = __builtin_amdgcn_readfirstlane(threadIdx.x >> 6);
    LAS bf16_t* R = (LAS bf16_t*)(lds + wid * 16384);
    LAS bf16_t* YL = (LAS bf16_t*)lds;
    LAS bf16_t* P0 = (LAS bf16_t*)(lds + LDS_TAB + 16384);
    LAS bf16_t* tab = (LAS bf16_t*)(lds + LDS_TAB);
    { const int t0 = tid_();
#pragma unroll
      for (int i = 0; i < 2; ++i) { const int q = t0 + 512 * i, tb = q >> 9, row = (q >> 3) & 63, ch = q & 7;
          *(LAS u32x4*)(tab + tb * 4096 + row * 64 + ((ch ^ ((row >> 1) & 7)) << 3)) = *(const u32x4*)(p.FT + 16384 + row * 128 + tb * 64 + ch * 8); }
      __syncthreads(); }
    for (int r = 0;; ++r) {
        const int tid = tid_(), lane = tid & 63;
        int item;
        if (nblk == 256) { if (r >= 1) break; const int xcd = bid & 7, slot = bid >> 3; item = (xcd * 4 + (slot >> 3)) * 8 + (slot & 7); }
        else { item = bid + r * nblk; if (item >= 256) break; }
        const int bg = item >> 3, b = bg >> 2, g = bg & 3, i = item & 7, cp = 8 * i + wid;
        const bf16_t* rows = p.GT + ((size_t)b * 512 + g * 128) * 4096;
        f32x4 Y[4][4];
        const int npass = (wid == 0 && i == 0) ? 2 : 1;
#pragma unroll 1
        for (int pass = 0; pass < npass; ++pass) {
            const int cq = pass ? 64 : cp; const bool sz = (cq == 0) || (cq == 64);
            int ln = lane; asm volatile("" : "+v"(ln));
            fft_wave(rows + (size_t)cq * 4096, rows + (size_t)(sz ? 65 : 64 + cq) * 4096, sz, R, tab, ln, Y);
            if (wid == 0 && pass == 0) fft_put(P0, ln, Y);
        }
        __syncthreads();
        if (wid != 0 || i == 0) fft_put(YL + wid * 4352, lane, Y);
        __syncthreads();
        { const int k2 = tid & 63;
          bf16_t* dst = p.MIX + (size_t)b * 4096 * 1024 + g * 128 + 8 * i;
#pragma unroll 1
          for (int ii = 0; ii < 8; ++ii) { const int k1 = (tid >> 6) + 8 * ii, own = k1 * 68 + k2;
              const int k1m = (64 - k1) & 63, k2m = k1 == 0 ? ((64 - k2) & 63) : 63 - k2, mir = k1m * 68 + k2m;
              u32x4 o, m;
              o[0] = (unsigned)P0[own] | ((unsigned)YL[4352 + own] << 16);
              m[0] = (unsigned)(i == 0 ? YL[own] : P0[mir]) | ((unsigned)YL[4352 + mir] << 16);
#pragma unroll
              for (int w2 = 1; w2 < 4; ++w2) { o[w2] = (unsigned)YL[(2 * w2) * 4352 + own] | ((unsigned)YL[(2 * w2 + 1) * 4352 + own] << 16);
                                               m[w2] = (unsigned)YL[(2 * w2) * 4352 + mir] | ((unsigned)YL[(2 * w2 + 1) * 4352 + mir] << 16); }
              bf16_t* pt = dst + (size_t)(k1 + 64 * k2) * 1024;
              *(u32x4*)pt = o; *(u32x4*)(pt + 64) = m; } }
        __syncthreads();
    }
}

#define XB_TMO      128
#define XB_XCNT(j)  (256  + 64 * (j))
#define XB_XSUB(j)  (1280 + 64 * (j))
#define XB_XGEN(j)  (2304 + 64 * (j))
#define XB_TOP      3328
#define XB_TOPGEN   3392
#define XCD_BAR_WORDS 3456
#define XB_SPIN_CAP (1u << 22)
__device__ __forceinline__ unsigned xb_ld(unsigned* p)              { return __hip_atomic_load(p, __ATOMIC_RELAXED, __HIP_MEMORY_SCOPE_AGENT); }
__device__ __forceinline__ unsigned xb_add(unsigned* p, unsigned v) { return __hip_atomic_fetch_add(p, v, __ATOMIC_RELAXED, __HIP_MEMORY_SCOPE_AGENT); }
__device__ __forceinline__ unsigned xb_xcc_id() { return (unsigned)__builtin_amdgcn_s_getreg((3 << 11) | 20) & 0xFu; }
#define XB_SPIN(cond, bar) do { unsigned _sp = 0; while (cond) { __builtin_amdgcn_s_sleep(1); \
    if ((++_sp & 255u) == 0u) { if (xb_ld(&(bar)[XB_TMO])) break; if (_sp > XB_SPIN_CAP) { atomicAdd(&(bar)[XB_TMO], 1u); break; } } } } while (0)
struct XcdBarrier { unsigned* bar; unsigned x; volatile LAS unsigned* st; };
__device__ __forceinline__ XcdBarrier xcd_barrier_post(unsigned* bar, volatile LAS unsigned* st) {
    XcdBarrier b; b.bar = bar; b.x = xb_xcc_id(); b.st = st;
    if (threadIdx.x == 0) (void)xb_add(&bar[XB_XCNT(b.x)], 1u);
    return b;
}
__device__ __forceinline__ void xcd_barrier_complete(unsigned* bar, unsigned x, unsigned& nloc, unsigned& nx) {
    const unsigned G = gridDim.x * gridDim.y * gridDim.z;
    unsigned sum, cnt, mine, sp = 0u;
    for (;;) {
        sum = 0u; cnt = 0u; mine = 0u;
#pragma unroll
        for (unsigned j = 0; j < 16; ++j) { const unsigned c = xb_ld(&bar[XB_XCNT(j)]); sum += c; cnt += (c > 0u) ? 1u : 0u; mine = (j == x) ? c : mine; }
        if (sum == G) break;
        __builtin_amdgcn_s_sleep(1);
        if ((++sp & 255u) == 0u) { if (xb_ld(&bar[XB_TMO])) break; if (sp > XB_SPIN_CAP) { atomicAdd(&bar[XB_TMO], 1u); break; } }
    }
    nloc = mine > 0u ? mine : 1u; nx = cnt > 0u ? cnt : 1u;
}
__device__ __forceinline__ void xcd_barrier(const XcdBarrier& b) {
    asm volatile("s_waitcnt vmcnt(0)" ::: "memory");
    __syncthreads();
    if (threadIdx.x == 0) {
        unsigned* bar = b.bar;
        __builtin_amdgcn_s_waitcnt(0);
        unsigned nloc = b.st[0], nx = b.st[1];
        if (nloc == 0u) { xcd_barrier_complete(bar, b.x, nloc, nx); b.st[0] = nloc; b.st[1] = nx; }
        const unsigned old = xb_add(&bar[XB_XSUB(b.x)], 1u);
        const unsigned gen = old / nloc;
        if (old + 1u == (gen + 1u) * nloc) {
            __builtin_amdgcn_fence(__ATOMIC_RELEASE, "agent");
            asm volatile("s_waitcnt vmcnt(0)" ::: "memory");
            const unsigned og = xb_add(&bar[XB_TOP], 1u);
            const unsigned tg = og / nx;
            if (og + 1u == (tg + 1u) * nx) xb_add(&bar[XB_TOPGEN], 1u);
            else XB_SPIN(xb_ld(&bar[XB_TOPGEN]) == tg, bar);
            __builtin_amdgcn_fence(__ATOMIC_ACQUIRE, "agent");
            xb_add(&bar[XB_XGEN(b.x)], 1u);
            asm volatile("s_waitcnt vmcnt(0)" ::: "memory");
        } else {
            XB_SPIN(xb_ld(&bar[XB_XGEN(b.x)]) == gen, bar);
            __builtin_amdgcn_fence(__ATOMIC_ACQUIRE, "agent");
            asm volatile("s_waitcnt vmcnt(0)" ::: "memory");
        }
    }
    __syncthreads();
}

constexpr int PH_PER_LAYER = 9, N_PHASES = 1 + NLAYER * PH_PER_LAYER;

__device__ __forceinline__ void run_phase(const Params& p, int ph, LAS unsigned char* lds, int bid, int nblk) {
    if (ph == 0) { phase_prep(p, lds, bid, nblk); return; }
    const int l = (ph - 1) / PH_PER_LAYER, s = (ph - 1) % PH_PER_LAYER;
    const bf16_t* W = p.Wt + (size_t)l * W_LAYER;
    pg8::StaticOrder S;
    switch (s) {
    case 0: {
        { pg8::Gemm g{W + W_IN, p.XB, 512, NTOK, 1024}; S.init(g.M, g.N, nblk, bid); EpiGT E{p.GT, p.rstd}; pg8::gemm_phase(lds, g, S, E); }
        { pg8::Gemm g{p.XB, W + W_IN + (size_t)1024 * 1024, NTOK, 2048, 1024}; S.init(g.M, g.N, nblk, bid);
          EpiRest E{p.Q, p.K, p.V, p.G, p.LAF, p.LAB, p.rstd, p.b_af + l * 256, p.b_ab + l * 256}; pg8::gemm_phase(lds, g, S, E); }
    } break;
    case 1: phase_gla_state(p, lds, bid, nblk); break;
    case 2: phase_fft(p, lds, bid, nblk); phase_gla_scan(p, bid, nblk); break;
    case 3: phase_gla_out(p, l, lds, bid, nblk); break;
    case 4: case 7: {
        pg8::Gemm g = (s == 4) ? pg8::Gemm{p.MIX, W + W_OUT, NTOK, 1024, 1024} : pg8::Gemm{p.HMID, W + W_D, NTOK, 1024, DFF};
        S.init(g.M, g.N, nblk, bid); EpiMF E{p.MF, p.ssqp}; pg8::gemm_phase(lds, g, S, E);
    } break;
    case 5: phase_row(p, l == 0 ? p.x : nullptr, p.norm_mix_post + l * DM, false, bid, nblk); break;
    case 6: { pg8::Gemm g{p.XB, W + W_GU, NTOK, 2 * DFF, 1024}; S.init(g.M, g.N, nblk, bid); EpiGU E{p.HMID, p.rstd}; pg8::gemm_phase(lds, g, S, E); } break;
    case 8: phase_row(p, nullptr, p.norm_ffn_post + l * DM, l == NLAYER - 1, bid, nblk); break;
    }
}

#if !ONE_LAUNCH
__global__ void __launch_bounds__(512, 2) k_phase(Params p, int ph) {
    extern __shared__ __attribute__((aligned(16))) unsigned char shm[];
    run_phase(p, ph, (LAS unsigned char*)shm, blockIdx.x, gridDim.x);
}
#else
__global__ void __launch_bounds__(512, 2) k_mega(Params p) {
    extern __shared__ __attribute__((aligned(16))) unsigned char shm[];
    cg::grid_group grid = cg::this_grid();
    volatile LAS unsigned* st = (volatile LAS unsigned*)((LAS unsigned char*)shm + LDS_STAGE);
    if (threadIdx.x == 0) { st[0] = 0u; st[1] = 0u; st[2] = 0u; st[3] = 0u; }
    __syncthreads();
    const XcdBarrier xb = xcd_barrier_post(p.bar, st);
    for (int ph = 0; ph < N_PHASES; ++ph) {
        int bidv = blockIdx.x; asm volatile("" : "+s"(bidv));
        run_phase(p, ph, (LAS unsigned char*)shm, bidv, gridDim.x);
#if PROBE_DBL
        { const int s_ = ph ? (ph - 1) % PH_PER_LAYER : -1;
          const bool dbl = ((PROBE_DBL & 1) && ph == 0) || ((PROBE_DBL & 2) && (s_ == 1 || s_ == 3)) || ((PROBE_DBL & 4) && (s_ == 0 || s_ == 4 || s_ == 6 || s_ == 7)) || ((PROBE_DBL & 8) && s_ == 2) || ((PROBE_DBL & 16) && s_ == 6) || ((PROBE_DBL & 32) && s_ == 7) || ((PROBE_DBL & 64) && s_ == 0) || ((PROBE_DBL & 128) && s_ == 4);
          if (dbl) { xcd_barrier(xb); if (s_ == 2) phase_fft(p, (LAS unsigned char*)shm, blockIdx.x, gridDim.x); else run_phase(p, ph, (LAS unsigned char*)shm, blockIdx.x, gridDim.x); } }
#endif
        if (ph + 1 < N_PHASES) { if (ph == 0) grid.sync(); else xcd_barrier(xb); }
    }
}
#endif

extern "C" void kernel_launch(void* const* d_in, const int* in_sizes, int n_in, void* d_out, int out_size, void* d_ws, size_t ws_size, hipStream_t stream) {
    Params p{};
    p.x = (const float*)d_in[0]; p.norm_mix_pre = (const float*)d_in[1]; p.w_in = (const float*)d_in[2]; p.w_af = (const float*)d_in[3]; p.b_af = (const float*)d_in[4];
    p.w_ab = (const float*)d_in[5]; p.b_ab = (const float*)d_in[6]; p.onorm = (const float*)d_in[7]; p.w_out = (const float*)d_in[8]; p.norm_mix_post = (const float*)d_in[9];
    p.norm_ffn_pre = (const float*)d_in[10]; p.w_g = (const float*)d_in[11]; p.w_u = (const float*)d_in[12]; p.w_d = (const float*)d_in[13]; p.norm_ffn_post = (const float*)d_in[14];
    p.out = (float*)d_out;
    unsigned char* ws = (unsigned char*)d_ws; size_t o = 0;
    p.Wt = (bf16_t*)(ws + o); o += NLAYER * W_LAYER * 2;
    p.FT = (bf16_t*)(ws + o); o += (size_t)65536;
    p.XB = (bf16_t*)(ws + o); o += (size_t)NTOK * DM * 2;
    p.MIX = (bf16_t*)(ws + o); o += (size_t)NTOK * DM * 2;
    p.rstd = (float*)(ws + o); o += (size_t)NTOK * 4;
    p.ssqp = (float*)(ws + o); o += (size_t)NTOK * 16 * 4;
    p.decf = (float*)(ws + o); o += (size_t)2048 * 64 * 4;
    p.decb = (float*)(ws + o); o += (size_t)2048 * 64 * 4;
    p.bar = (unsigned*)(ws + o); o += (size_t)16384;
    unsigned char* T = ws + o;
    p.HMID = (bf16_t*)T;
    p.GT = (bf16_t*)T;
    p.Q = (bf16_t*)(T + 67108864); p.K = (bf16_t*)(T + 83886080); p.V = (bf16_t*)(T + 100663296); p.G = (bf16_t*)(T + 134217728);
    p.LAF = (bf16_t*)(T + 167772160); p.LAB = (bf16_t*)(T + 184549376); p.CSF = (bf16_t*)(T + 201326592); p.CSB = (bf16_t*)(T + 234881024);
    p.MF = (bf16_t*)(T + 184549376);
    const size_t need = o + 268435456;
    if (ws_size < need) { fprintf(stderr, "kernel_launch: workspace too small: %zu < %zu\n", ws_size, need); return; }
#if ONE_LAUNCH
    static int grid = 0;
    if (!grid) {
        int dev = 0, cus = 0, per_cu = 0;
        hipGetDevice(&dev); hipDeviceGetAttribute(&cus, hipDeviceAttributeMultiprocessorCount, dev);
        hipFuncSetAttribute((const void*)k_mega, hipFuncAttributeMaxDynamicSharedMemorySize, LDS_BYTES);
        hipOccupancyMaxActiveBlocksPerMultiprocessor(&per_cu, (const void*)k_mega, NTHREADS, LDS_BYTES);
        if (per_cu < 1) per_cu = 1;
        grid = cus * per_cu;
    }
    hipMemsetAsync(p.bar, 0, XCD_BAR_WORDS * sizeof(unsigned), stream);
    void* args[] = {&p};
    hipError_t e = hipLaunchCooperativeKernel((const void*)k_mega, dim3(grid), dim3(NTHREADS), args, LDS_BYTES, stream);
    if (e != hipSuccess) fprintf(stderr, "cooperative launch failed: %s (grid %d)\n", hipGetErrorString(e), grid);
#else
    hipFuncSetAttribute((const void*)k_phase, hipFuncAttributeMaxDynamicSharedMemorySize, LDS_BYTES);
    for (int ph = 0; ph < N_PHASES; ++ph) hipLaunchKernelGGL(k_phase, dim3(256), dim3(NTHREADS), LDS_BYTES, stream, p, ph);
#endif
}
```

```cpp
#include <hip/hip_runtime.h>
#include <hip/hip_cooperative_groups.h>
#include <cstdio>
namespace cg = cooperative_groups;

#ifndef ONE_LAUNCH
#define ONE_LAUNCH 1
#endif

#ifndef PROBE_DBL
#define PROBE_DBL 0
#endif
#define LAS __attribute__((address_space(3)))
typedef unsigned short bf16_t;
typedef short bf16x8 __attribute__((ext_vector_type(8)));
typedef float f32x4 __attribute__((ext_vector_type(4)));
typedef unsigned u32x4 __attribute__((ext_vector_type(4)));
typedef unsigned u32x2 __attribute__((ext_vector_type(2)));

constexpr int DM = 1024, SEQ = 4096, NTOK = 32768, DFF = 2816, INC = 2080, NLAYER = 2;
constexpr int LDS_STAGE = 131072;
constexpr int LDS_TAB = LDS_STAGE + 16;
constexpr int LDS_BYTES = LDS_TAB + 16384 + 8704;
constexpr int NTHREADS = 512;
constexpr size_t W_IN = 0, W_OUT = 3145728, W_GU = 4194304, W_D = 9961472, W_LAYER = 12845056;

struct Params {
    const float *x, *norm_mix_pre, *w_in, *w_af, *b_af, *w_ab, *b_ab, *onorm, *w_out, *norm_mix_post, *norm_ffn_pre, *w_g, *w_u, *w_d, *norm_ffn_post;
    float* out;
    bf16_t *Wt, *FT, *XB, *MIX, *MF, *GT, *Q, *K, *V, *G, *LAF, *LAB, *CSF, *CSB, *HMID;
    float *rstd, *ssqp, *decf, *decb;
    unsigned* bar; unsigned* xch; unsigned* cnt;
};

__device__ __forceinline__ int tid_() { int t = threadIdx.x; asm volatile("" : "+v"(t)); return t; }
__device__ __forceinline__ float bf2f(unsigned b) { return __uint_as_float(b << 16); }
__device__ __forceinline__ float bflo(unsigned w) { return __uint_as_float(w << 16); }
__device__ __forceinline__ float bfhi(unsigned w) { return __uint_as_float(w & 0xffff0000u); }
typedef __bf16 bf2_t __attribute__((ext_vector_type(2)));
typedef float f2_t __attribute__((ext_vector_type(2)));
__device__ __forceinline__ unsigned pk2(float lo, float hi) { f2_t f = {lo, hi}; bf2_t b = __builtin_convertvector(f, bf2_t); return __builtin_bit_cast(unsigned, b); }
__device__ __forceinline__ bf16_t f2bf(float f) { return (bf16_t)(pk2(f, 0.f) & 0xffffu); }

namespace pg8 {
constexpr int BM = 256, BK = 64, HALF = 128, HTB = HALF * BK * 2, NXCD = 8, WGM = 8;
__device__ __forceinline__ int lds_byte(int r, int c) { const int st = (r >> 4) * 2 + (c >> 5), rr = r & 15, cc = c & 31, ob = rr * 64 + cc * 2; return st * 1024 + (ob ^ (((ob >> 9) & 1) << 5)); }
__device__ __forceinline__ void stage_rc(int b, int& R, int& C) { const int st = b / 1024, sb = b % 1024, swz = sb ^ (((sb >> 9) & 1) << 5); R = (st >> 1) * 16 + swz / 64; C = (st & 1) * 32 + (swz % 64) / 2; }
__device__ __forceinline__ int perm32(int rho) { const int n = rho >> 4, i = rho & 15; return 8 * (i >> 2) + 4 * n + (i & 3); }
struct Unit { int pm, pn, kind; };
struct Gemm { const bf16_t* A; const bf16_t* Bt; int M, N, K; };
struct StaticOrder {
    int nM, nN, nwg, G, c, i0, ni;
    __device__ void init(int M, int N, int G_, int c_) { nM = M / BM; nN = N / BM; nwg = nM * nN; G = G_; c = c_; i0 = 0; ni = 1 << 30; }
    __device__ bool next(int i, Unit& u) const {
        if (i >= ni) return false;
        const long L = (long)(i + i0) * G + c; if (L >= nwg) return false;
        int wgid = (int)L; { const int q = nwg / NXCD, r = nwg % NXCD, xcd = wgid % NXCD, off = wgid / NXCD; wgid = (xcd < r ? xcd * (q + 1) : r * (q + 1) + (xcd - r) * q) + off; }
        const int nig = WGM * nN, gid = wgid / nig, fm = gid * WGM, gsz = (nM - fm) < WGM ? (nM - fm) : WGM;
        u.pm = fm + ((wgid % nig) % gsz); u.pn = (wgid % nig) / gsz; return true;
    }
};

template <int M, int N>
__device__ __forceinline__ bool unit_at(int i, int c, int i0, int ni, Unit& u) {
    constexpr int nM = M / BM, nN = N / BM, nwg = nM * nN, G = 256;
    constexpr int gsz = (nM % WGM == 0) ? WGM : nM;
    static_assert(nM % WGM == 0 || nM < WGM, "row tiles: a multiple of 8, or fewer than 8");
    if (i >= ni) return false;
    const int L = (i + i0) * G + c; if (L >= nwg) return false;
    int wgid = L; { constexpr int q = nwg / NXCD, r = nwg % NXCD; const int xcd = wgid % NXCD, off = wgid / NXCD; wgid = (xcd < r ? xcd * (q + 1) : r * (q + 1) + (xcd - r) * q) + off; }
    constexpr int nig = gsz * nN; const int gid = wgid / nig, fm = gid * gsz, w = wgid % nig;
    u.pm = fm + (w % gsz); u.pn = w / gsz; return true;
}

template <int M, int N, int K> struct SchedOne {
    const bf16_t* A; const bf16_t* Bt; int c, i0, ni;
    __device__ __forceinline__ bool at(int i, Unit& u) const { u.kind = 0; return unit_at<M, N>(i, c, i0, ni, u); }
    __device__ __forceinline__ const char* a(const Unit& u) const { return (const char*)A + (size_t)u.pm * (512 * K); }
    __device__ __forceinline__ const char* b(const Unit& u) const { return (const char*)Bt + (size_t)u.pn * (512 * K); }
};
struct SchedInProj {
    const bf16_t* W; const bf16_t* XB; int c;
    __device__ __forceinline__ bool at(int i, Unit& u) const {
        if (i == 0) { u.kind = 0; return unit_at<512, 32768>(0, c, 0, 1, u); }
        u.kind = 1; return unit_at<32768, 2048>(i - 1, c, 0, 1 << 30, u); }
    __device__ __forceinline__ const char* a(const Unit& u) const { return (const char*)(u.kind == 0 ? W : XB) + (size_t)u.pm * (512 * 1024); }
    __device__ __forceinline__ const char* b(const Unit& u) const { return (const char*)(u.kind == 0 ? XB : W + (size_t)1024 * 1024) + (size_t)u.pn * (512 * 1024); }
};

template <class Epi, class Sched, int K>
__device__ __forceinline__ void gemm_phase(LAS unsigned char* lds, const Sched& S, const Epi& E) {
    const int tid = tid_(), wid = __builtin_amdgcn_readfirstlane(tid >> 6), lane = tid & 63, wr = wid >> 2, wc = wid & 3, fr = lane & 15, fq = lane >> 4;
    constexpr int nt = K / BK;
    unsigned voffA[2], voffB[2];
#pragma unroll
    for (int i = 0; i < 2; ++i) { int R, C; stage_rc(tid * 16 + i * 8192, R, C); const int Rb = (R & ~31) + perm32(R & 31);
        voffA[i] = (unsigned)(R * K + C) * 2u; voffB[i] = (unsigned)(Rb * K + C) * 2u; }
    const size_t kstep = (size_t)(BK * 2);
    const size_t hstep = (size_t)HALF * K * 2;
    const size_t tstep = 2 * hstep;
    const unsigned ldsw = (unsigned)wid * 1024u;
    const int aoff = lds_byte(wr * 64 + fr, fq * 8), boff = lds_byte(wc * 32 + fr, fq * 8);
#define PG8_SA(b, h) (((b) * 2 + (h)) * HTB)
#define PG8_SB(b, h) ((4 + (b) * 2 + (h)) * HTB)
#define PG8_STAGE(bufoff, gbase, voff) do { _Pragma("unroll") for (int _i = 0; _i < 2; ++_i) \
        __builtin_amdgcn_global_load_lds((const unsigned*)((const char*)(gbase) + (voff)[_i]), (LAS unsigned*)(lds + (bufoff) + ldsw + _i * 8192), 16, 0, 0); } while (0)
#define PG8_LDA(dst, b, h) do { _Pragma("unroll") for (int m = 0; m < 4; ++m) _Pragma("unroll") for (int k = 0; k < 2; ++k) dst[m][k] = *(const LAS bf16x8*)(lds + PG8_SA(b, h) + aoff + m * 2048 + k * 1024); } while (0)
#define PG8_LDB(dst, b, h) do { _Pragma("unroll") for (int n = 0; n < 2; ++n) _Pragma("unroll") for (int k = 0; k < 2; ++k) dst[n][k] = *(const LAS bf16x8*)(lds + PG8_SB(b, h) + boff + n * 2048 + k * 1024); } while (0)
#define PG8_MMA(ai, bj, At, Bt) do { __builtin_amdgcn_s_setprio(1); _Pragma("unroll") for (int m = 0; m < 4; ++m) _Pragma("unroll") for (int n = 0; n < 2; ++n) _Pragma("unroll") for (int k = 0; k < 2; ++k) \
        acc[ai][bj][m][n] = __builtin_amdgcn_mfma_f32_16x16x32_bf16(Bt[n][k], At[m][k], acc[ai][bj][m][n], 0, 0, 0); __builtin_amdgcn_s_setprio(0); } while (0)
#define PG8_WAIT_V(n) asm volatile("s_waitcnt vmcnt(" #n ")" ::: "memory")
#define PG8_WAIT_L(n) asm volatile("s_waitcnt lgkmcnt(" #n ")" ::: "memory")
#define PG8_BAR __builtin_amdgcn_s_barrier()
#define PG8_SCHED __builtin_amdgcn_sched_barrier(0)
    Unit cur, nxt; int ui = 0;
    if (!S.at(0, cur)) return;
    f32x4 acc[2][2][4][2];
#pragma unroll
    for (int a = 0; a < 2; ++a)
#pragma unroll
        for (int b = 0; b < 2; ++b)
#pragma unroll
            for (int m = 0; m < 4; ++m)
#pragma unroll
                for (int n = 0; n < 2; ++n) acc[a][b][m][n] = (f32x4){0.f, 0.f, 0.f, 0.f};
    bf16x8 At[4][2], B0[2][2], B1[2][2];
    float epre[2] = {0.f, 0.f};
    const char* cA = S.a(cur); const char* cB = S.b(cur);
    PG8_STAGE(PG8_SB(0, 0), cB, voffB); PG8_STAGE(PG8_SA(0, 0), cA, voffA); PG8_STAGE(PG8_SB(0, 1), cB + hstep, voffB); PG8_STAGE(PG8_SA(0, 1), cA + hstep, voffA);
    if (wr == 1) PG8_BAR;
    PG8_WAIT_V(4); PG8_BAR;
    PG8_STAGE(PG8_SB(1, 0), cB + kstep, voffB); PG8_STAGE(PG8_SA(1, 0), cA + kstep, voffA); PG8_STAGE(PG8_SB(1, 1), cB + hstep + kstep, voffB);
    PG8_WAIT_V(6); PG8_BAR;
    for (;;) {
        const bool has_next = S.at(ui + 1, nxt);
        const char* nA = has_next ? S.a(nxt) : cA; const char* nB = has_next ? S.b(nxt) : cB;
        for (int t = 0; t < nt; t += 2) {
            const bool last = (t == nt - 2);
            const char* a1 = cA + (size_t)(t + 1) * kstep;
            const char* a2 = last ? nA : cA + (size_t)(t + 2) * kstep; const char* b2 = last ? nB : cB + (size_t)(t + 2) * kstep;
            const char* a3 = a2 + kstep; const char* b3 = b2 + kstep;
            if (last) E.pre(cur, wr, wc, lane, epre);
            PG8_LDB(B0, 0, 0); PG8_SCHED; PG8_LDA(At, 0, 0); PG8_STAGE(PG8_SA(1, 1), a1 + hstep, voffA);
            PG8_WAIT_L(8); PG8_BAR; PG8_WAIT_L(0); PG8_MMA(0, 0, At, B0); PG8_BAR; PG8_SCHED;
            PG8_LDB(B1, 0, 1); PG8_STAGE(PG8_SB(0, 0), b2, voffB);
            PG8_BAR; PG8_WAIT_L(0); PG8_MMA(0, 1, At, B1); PG8_BAR;
            PG8_LDA(At, 0, 1); PG8_STAGE(PG8_SA(0, 0), a2, voffA);
            PG8_BAR; PG8_WAIT_L(0); PG8_MMA(1, 0, At, B0); PG8_BAR; PG8_SCHED;
            PG8_STAGE(PG8_SB(0, 1), b2 + hstep, voffB);
            PG8_WAIT_V(6); PG8_BAR; PG8_MMA(1, 1, At, B1); PG8_BAR;
            PG8_LDB(B0, 1, 0); PG8_SCHED; PG8_LDA(At, 1, 0); PG8_STAGE(PG8_SA(0, 1), a2 + hstep, voffA);
            PG8_WAIT_L(8); PG8_BAR; PG8_WAIT_L(0); PG8_MMA(0, 0, At, B0); PG8_BAR; PG8_SCHED;
            PG8_LDB(B1, 1, 1); PG8_STAGE(PG8_SB(1, 0), b3, voffB);
            PG8_BAR; PG8_WAIT_L(0); PG8_MMA(0, 1, At, B1); PG8_BAR;
            PG8_LDA(At, 1, 1); PG8_STAGE(PG8_SA(1, 0), a3, voffA);
            PG8_BAR; PG8_WAIT_L(0); PG8_MMA(1, 0, At, B0); PG8_BAR; PG8_SCHED;
            PG8_STAGE(PG8_SB(1, 1), b3 + hstep, voffB);
            PG8_WAIT_V(6); PG8_BAR; PG8_MMA(1, 1, At, B1); PG8_BAR;
        }
        if constexpr (!Epi::AFTER_DRAIN) E(acc, cur, wr, wc, fr, fq, epre);
        else if (has_next) {
            if (wr == 0) PG8_BAR;
            E.fused(acc, cur, wr, wc, fr, fq, lds + LDS_TAB, wid, lane);
            if (wr == 1) PG8_BAR;
        }
        if (!has_next) break;
#pragma unroll
        for (int a = 0; a < 2; ++a)
#pragma unroll
            for (int b = 0; b < 2; ++b)
#pragma unroll
                for (int m = 0; m < 4; ++m)
#pragma unroll
                    for (int n = 0; n < 2; ++n) acc[a][b][m][n] = (f32x4){0.f, 0.f, 0.f, 0.f};
        cur = nxt; cA = nA; cB = nB; ++ui;
    }
    PG8_WAIT_V(0);
    if (wr == 0) PG8_BAR;
    PG8_BAR;
    if constexpr (Epi::AFTER_DRAIN) E.fused(acc, cur, wr, wc, fr, fq, lds + LDS_TAB, wid, lane);
#undef PG8_SA
#undef PG8_SB
#undef PG8_STAGE
#undef PG8_LDA
#undef PG8_LDB
#undef PG8_MMA
#undef PG8_WAIT_V
#undef PG8_WAIT_L
#undef PG8_BAR
#undef PG8_SCHED
}
}
using pg8::Unit;

typedef f32x4 AccT[2][2][4][2];

__device__ __forceinline__ float rstd_of(const float* ssq2p, int row) { const f32x4 q = *(const f32x4*)(ssq2p + (size_t)row * 4); return rsqrtf(((q[0] + q[1]) + (q[2] + q[3])) * (1.f / 1024.f) + 1e-6f); }
struct EpiGT {
    static constexpr bool AFTER_DRAIN = false;
    bf16_t* GT; const float* rstd;
    __device__ __forceinline__ void pre(const Unit& u, int wr, int wc, int lane, float (&r)[2]) const { r[0] = rstd_of(rstd, u.pn * 256 + (lane >> 5) * 128 + wc * 32 + (lane & 31)); }
    __device__ __forceinline__ void operator()(const AccT& acc, const Unit& u, int wr, int wc, int fr, int fq, const float (&epre)[2]) const {
        const int row0 = u.pm * 256 + wr * 64 + fr, tok0 = u.pn * 256 + wc * 32 + 8 * fq;
#pragma unroll
        for (int bj = 0; bj < 2; ++bj) {
            const int tok = tok0 + bj * 128;
            f32x4 r0, r1;
#pragma unroll
            for (int j = 0; j < 4; ++j) { r0[j] = __shfl(epre[0], bj * 32 + 8 * fq + j); r1[j] = __shfl(epre[0], bj * 32 + 8 * fq + 4 + j); }
            bf16_t* base = GT + (size_t)(tok >> 12) * (512 * 4096) + (tok & 4095);
#pragma unroll
            for (int ai = 0; ai < 2; ++ai)
#pragma unroll
                for (int m = 0; m < 4; ++m) {
                    const f32x4 v0 = acc[ai][bj][m][0] * r0, v1 = acc[ai][bj][m][1] * r1;
                    u32x4 o; o[0] = pk2(v0[0], v0[1]); o[1] = pk2(v0[2], v0[3]); o[2] = pk2(v1[0], v1[1]); o[3] = pk2(v1[2], v1[3]);
                    __builtin_nontemporal_store(o, (u32x4*)(base + (size_t)(row0 + ai * 128 + m * 16) * 4096));
                }
        }
    }
};
struct EpiRest {
    static constexpr bool AFTER_DRAIN = false;
    bf16_t *Q, *K, *V, *G, *LAF, *LAB; const float *rstd, *b_af, *b_ab;
    __device__ __forceinline__ void pre(const Unit& u, int wr, int wc, int lane, float (&r)[2]) const { const int row = u.pm * 256 + wr * 64 + lane; r[0] = rstd_of(rstd, row); r[1] = rstd_of(rstd, row + 128); }
    __device__ __forceinline__ void operator()(const AccT& acc, const Unit& u, int wr, int wc, int fr, int fq, const float (&epre)[2]) const {
        const int row0 = u.pm * 256 + wr * 64 + fr, cl0 = wc * 32 + 8 * fq;
        const int pn = u.pn;
        bf16_t* dst; int ld, coff = 0, mode = 0; const float* bias = nullptr;
        if (pn == 0) { dst = Q; ld = 256; }
        else if (pn == 1) { dst = K; ld = 256; }
        else if (pn < 4) { dst = V; ld = 512; coff = (pn - 2) * 256; }
        else if (pn < 6) { dst = G; ld = 512; coff = (pn - 4) * 256; mode = 1; }
        else if (pn == 6) { dst = LAF; ld = 256; mode = 2; bias = b_af; }
        else { dst = LAB; ld = 256; mode = 2; bias = b_ab; }
#pragma unroll
        for (int bj = 0; bj < 2; ++bj) {
            const int cl = cl0 + bj * 128;
            f32x4 bv0 = (f32x4){0.f, 0.f, 0.f, 0.f}, bv1 = bv0;
            if (mode == 2) { bv0 = *(const f32x4*)(bias + cl); bv1 = *(const f32x4*)(bias + cl + 4); }
#pragma unroll
            for (int ai = 0; ai < 2; ++ai)
#pragma unroll
                for (int m = 0; m < 4; ++m) {
                    const int row = row0 + ai * 128 + m * 16;
                    const float rs = __shfl(epre[ai], m * 16 + fr);
                    float v[8];
#pragma unroll
                    for (int j = 0; j < 4; ++j) { v[j] = acc[ai][bj][m][0][j] * rs; v[4 + j] = acc[ai][bj][m][1][j] * rs; }
                    if (mode == 2) {
#pragma unroll
                        for (int j = 0; j < 8; ++j) v[j] += (j < 4 ? bv0[j] : bv1[j - 4]);
                    }
                    u32x4 o; o[0] = pk2(v[0], v[1]); o[1] = pk2(v[2], v[3]); o[2] = pk2(v[4], v[5]); o[3] = pk2(v[6], v[7]);
                    __builtin_nontemporal_store(o, (u32x4*)(dst + (size_t)row * ld + coff + cl));
                }
        }
    }
};
struct EpiIn {
    static constexpr bool AFTER_DRAIN = false;
    EpiGT gt; EpiRest rest;
    __device__ __forceinline__ void pre(const Unit& u, int wr, int wc, int lane, float (&r)[2]) const { if (u.kind == 0) gt.pre(u, wr, wc, lane, r); else rest.pre(u, wr, wc, lane, r); }
    __device__ __forceinline__ void operator()(const AccT& acc, const Unit& u, int wr, int wc, int fr, int fq, const float (&epre)[2]) const {
        if (u.kind == 0) gt(acc, u, wr, wc, fr, fq, epre); else rest(acc, u, wr, wc, fr, fq, epre); }
};
struct EpiMF {
    static constexpr bool AFTER_DRAIN = false;
    bf16_t* MF; float* ssqp;
    __device__ __forceinline__ void pre(const Unit&, int, int, int, float (&)[2]) const {}
    __device__ __forceinline__ void operator()(const AccT& acc, const Unit& u, int wr, int wc, int fr, int fq, const float (&epre)[2]) const {
        const int row0 = u.pm * 256 + wr * 64 + fr, c0 = u.pn * 256 + wc * 32 + 8 * fq;
#pragma unroll
        for (int ai = 0; ai < 2; ++ai)
#pragma unroll
            for (int m = 0; m < 4; ++m) {
                const int row = row0 + ai * 128 + m * 16;
                float ss = 0.f;
#pragma unroll
                for (int bj = 0; bj < 2; ++bj) {
                    const f32x4 v0 = acc[ai][bj][m][0], v1 = acc[ai][bj][m][1];
                    u32x4 o; o[0] = pk2(v0[0], v0[1]); o[1] = pk2(v0[2], v0[3]); o[2] = pk2(v1[0], v1[1]); o[3] = pk2(v1[2], v1[3]);
                    __builtin_nontemporal_store(o, (u32x4*)(MF + (size_t)row * 1024 + c0 + bj * 128));
#pragma unroll
                    for (int j = 0; j < 4; ++j) ss += v0[j] * v0[j] + v1[j] * v1[j];
                }
                ss += __shfl_xor(ss, 16); ss += __shfl_xor(ss, 32);
                if (fq == 0) ssqp[(size_t)row * 16 + u.pn * 4 + wc] = ss;
            }
    }
};
struct EpiRes {
    static constexpr bool AFTER_DRAIN = true;
    bf16_t* XB; float* out; const float* wpost; float* ssq2p; unsigned* xch; unsigned tag; int last;
    __device__ __forceinline__ void pre(const Unit&, int, int, int, float (&)[2]) const {}
    __device__ __forceinline__ void fused(const AccT& acc, const Unit& u, int wr, int wc, int fr, int fq, LAS unsigned char* lds, int wid, int lane) const {
        asm volatile("" : "+v"(fr), "+v"(fq), "+v"(lane));
        LAS float* P = (LAS float*)lds;
        LAS float* S = (LAS float*)(lds + 4096);
        const int c0 = u.pn * 256 + wc * 32 + 8 * fq;
        u32x4 xbv[2][4][2];
#pragma unroll
        for (int m = 0; m < 4; ++m)
#pragma unroll
            for (int bj = 0; bj < 2; ++bj) xbv[0][m][bj] = *(const u32x4*)(XB + (size_t)(u.pm * 256 + wr * 64 + m * 16 + fr) * 1024 + c0 + bj * 128);
#pragma unroll
        for (int ai = 0; ai < 2; ++ai)
#pragma unroll
            for (int m = 0; m < 4; ++m) { float ss = 0.f;
#pragma unroll
                for (int bj = 0; bj < 2; ++bj)
#pragma unroll
                    for (int n = 0; n < 2; ++n) { const f32x4 v = acc[ai][bj][m][n]; ss += (v[0] * v[0] + v[1] * v[1]) + (v[2] * v[2] + v[3] * v[3]); }
                ss += __shfl_xor(ss, 16); ss += __shfl_xor(ss, 32);
                if (fq == 0) P[(ai * 128 + wr * 64 + m * 16 + fr) * 4 + wc] = ss; }
        asm volatile("s_waitcnt lgkmcnt(0)" ::: "memory"); __builtin_amdgcn_s_barrier(); asm volatile("" ::: "memory");
        const int row = wid * 32 + (lane & 31);
        if (lane < 32) {
            const float t = (P[row * 4] + P[row * 4 + 1]) + (P[row * 4 + 2] + P[row * 4 + 3]);
            unsigned long long* sl = (unsigned long long*)xch + (size_t)(u.pm * 256 + row) * 4;
            __hip_atomic_store(sl + u.pn, ((unsigned long long)tag << 32) | (unsigned long long)__float_as_uint(t), __ATOMIC_RELAXED, __HIP_MEMORY_SCOPE_AGENT);
            unsigned spins = 0u; float tot = 0.f;
#pragma unroll
            for (int q = 0; q < 4; ++q) { unsigned long long w;
                for (;;) { w = __hip_atomic_load(sl + q, __ATOMIC_RELAXED, __HIP_MEMORY_SCOPE_AGENT);
                    if ((unsigned)(w >> 32) == tag) break;
                    if (++spins > (1u << 20)) break;
                    __builtin_amdgcn_s_sleep(1); }
                tot += __uint_as_float((unsigned)w); }
            S[row] = rsqrtf(tot * (1.f / 1024.f) + 1e-6f); }
        asm volatile("s_waitcnt vmcnt(0) lgkmcnt(0)" ::: "memory"); __builtin_amdgcn_s_barrier(); asm volatile("" ::: "memory");
        f32x4 wv[2][2];
#pragma unroll
        for (int bj = 0; bj < 2; ++bj) { wv[bj][0] = *(const f32x4*)(wpost + c0 + bj * 128); wv[bj][1] = *(const f32x4*)(wpost + c0 + bj * 128 + 4); }
#pragma unroll
        for (int m = 0; m < 4; ++m)
#pragma unroll
            for (int bj = 0; bj < 2; ++bj) xbv[1][m][bj] = *(const u32x4*)(XB + (size_t)(u.pm * 256 + 128 + wr * 64 + m * 16 + fr) * 1024 + c0 + bj * 128);
#pragma unroll
        for (int ai = 0; ai < 2; ++ai)
#pragma unroll
            for (int m = 0; m < 4; ++m) { const int r = ai * 128 + wr * 64 + m * 16 + fr; const float rs = S[r]; const size_t off = (size_t)(u.pm * 256 + r) * 1024 + c0;
                float s2 = 0.f;
#pragma unroll
                for (int bj = 0; bj < 2; ++bj) { const u32x4 xb = xbv[ai][m][bj];
                    const f32x4 a0 = acc[ai][bj][m][0], a1 = acc[ai][bj][m][1]; float v[8];
#pragma unroll
                    for (int j = 0; j < 2; ++j) { v[2 * j] = bflo(xb[j]) + a0[2 * j] * rs * wv[bj][0][2 * j]; v[2 * j + 1] = bfhi(xb[j]) + a0[2 * j + 1] * rs * wv[bj][0][2 * j + 1];
                                                  v[4 + 2 * j] = bflo(xb[2 + j]) + a1[2 * j] * rs * wv[bj][1][2 * j]; v[4 + 2 * j + 1] = bfhi(xb[2 + j]) + a1[2 * j + 1] * rs * wv[bj][1][2 * j + 1]; }
#pragma unroll
                    for (int j = 0; j < 8; ++j) s2 += v[j] * v[j];
                    if (last) { *(f32x4*)(out + off + bj * 128) = (f32x4){v[0], v[1], v[2], v[3]}; *(f32x4*)(out + off + bj * 128 + 4) = (f32x4){v[4], v[5], v[6], v[7]}; }
                    else { u32x4 o; o[0] = pk2(v[0], v[1]); o[1] = pk2(v[2], v[3]); o[2] = pk2(v[4], v[5]); o[3] = pk2(v[6], v[7]); *(u32x4*)(XB + off + bj * 128) = o; } }
                s2 += __shfl_xor(s2, 16); s2 += __shfl_xor(s2, 32);
                if (fq == 0) P[r * 4 + wc] = s2; }
        asm volatile("s_waitcnt lgkmcnt(0)" ::: "memory"); __builtin_amdgcn_s_barrier(); asm volatile("" ::: "memory");
        if (lane < 32 && !last) ssq2p[(size_t)(u.pm * 256 + row) * 4 + u.pn] = (P[row * 4] + P[row * 4 + 1]) + (P[row * 4 + 2] + P[row * 4 + 3]);
        asm volatile("s_waitcnt lgkmcnt(0)" ::: "memory"); __builtin_amdgcn_s_barrier(); asm volatile("" ::: "memory");
    }
};
struct EpiGU {
    static constexpr bool AFTER_DRAIN = false;
    bf16_t* H; const float* rstd;
    __device__ __forceinline__ void pre(const Unit& u, int wr, int wc, int lane, float (&r)[2]) const { const int row = u.pm * 256 + wr * 64 + lane; r[0] = rstd_of(rstd, row); r[1] = rstd_of(rstd, row + 128); }
    __device__ __forceinline__ void operator()(const AccT& acc, const Unit& u, int wr, int wc, int fr, int fq, const float (&epre)[2]) const {
        const int row0 = u.pm * 256 + wr * 64 + fr, c0 = u.pn * 128 + wc * 32 + 8 * fq;
#pragma unroll
        for (int ai = 0; ai < 2; ++ai)
#pragma unroll
            for (int m = 0; m < 4; ++m) {
                const int row = row0 + ai * 128 + m * 16;
                const float rs = __shfl(epre[ai], m * 16 + fr);
                float h[8];
#pragma unroll
                for (int n = 0; n < 2; ++n)
#pragma unroll
                    for (int j = 0; j < 4; ++j) { const float gg = acc[ai][0][m][n][j] * rs, uu = acc[ai][1][m][n][j] * rs; h[n * 4 + j] = gg * uu * __builtin_amdgcn_rcpf(1.f + __builtin_amdgcn_exp2f(gg * -1.4426950408889634f)); }
                u32x4 o; o[0] = pk2(h[0], h[1]); o[1] = pk2(h[2], h[3]); o[2] = pk2(h[4], h[5]); o[3] = pk2(h[6], h[7]);
                __builtin_nontemporal_store(o, (u32x4*)(H + (size_t)row * DFF + c0));
            }
    }
};

#define MFMA16(a, b, c) __builtin_amdgcn_mfma_f32_16x16x32_bf16((a), (b), (c), 0, 0, 0)
struct TrDesc { const float* src; bf16_t* dst; const float* gain; int ld, ldd; float scale; int mir; };
__device__ __forceinline__ void tr_desc(const Params& p, int it, TrDesc& d) {
    const int l = it / 2752; int t = it % 2752;
    bf16_t* W = p.Wt + (size_t)l * W_LAYER;
    d.mir = 0;
    if (t < 384) {
        const int ct = t >> 4, kt = t & 15, c0 = 512 + ct * 64;
        d.src = p.w_in + (size_t)l * DM * INC + (size_t)(kt * 64) * INC + c0; d.ld = INC; d.dst = W + W_IN + (size_t)(1024 + ct * 64) * 1024 + kt * 64; d.ldd = 1024; d.gain = p.norm_mix_pre + l * DM + kt * 64; d.scale = c0 < 768 ? 0.125f : 1.f;
    } else if (t < 640) {
        t -= 384; const int ct = t >> 4, kt = t & 15;
        d.src = p.w_out + (size_t)l * DM * DM + (size_t)(kt * 64) * DM + ct * 64; d.ld = DM; d.dst = W + W_OUT + (size_t)(ct * 64) * 1024 + kt * 64; d.ldd = 1024; d.gain = nullptr; d.scale = 1.f;
        if (kt < 8 && (kt & 1)) { d.mir = 1; d.src = p.w_out + (size_t)l * DM * DM + (size_t)((kt >> 1) * 128) * DM + ct * 64; }
    } else if (t < 2048) {
        t -= 640; const int up = t >= 704; if (up) t -= 704; const int ct = t >> 4, kt = t & 15, c0 = ct * 64;
        d.src = (up ? p.w_u : p.w_g) + (size_t)l * DM * DFF + (size_t)(kt * 64) * DFF + c0; d.ld = DFF; d.dst = W + W_GU + (size_t)(256 * (c0 >> 7) + (c0 & 127) + (up ? 128 : 0)) * 1024 + kt * 64; d.ldd = 1024; d.gain = p.norm_ffn_pre + l * DM + kt * 64; d.scale = 1.f;
    } else {
        t -= 2048; const int ct = t / 44, kt = t % 44;
        d.src = p.w_d + (size_t)l * DFF * DM + (size_t)(kt * 64) * DM + ct * 64; d.ld = DM; d.dst = W + W_D + (size_t)(ct * 64) * DFF + kt * 64; d.ldd = DFF; d.gain = nullptr; d.scale = 1.f;
    }
}
struct TrRegs { f32x4 v[2]; float g[2]; };
__device__ __forceinline__ void tr_load(const TrDesc& d, int tid, TrRegs& r) {
#pragma unroll
    for (int i = 0; i < 2; ++i) { const int idx = tid + i * 512, rr = idx >> 4, c4 = (idx & 15) * 4;
        const int srow = d.mir ? (rr == 0 ? 64 : 128 - rr) : rr;
        r.v[i] = *(const f32x4*)(d.src + (size_t)srow * d.ld + c4);
        r.g[i] = d.gain ? d.gain[rr] * d.scale : d.scale; }
}

__device__ void phase_prep(const Params& p, LAS unsigned char* lds, int bid, int nblk) {
    const int tid = tid_();
    LAS float* tile = (LAS float*)lds;
    if (bid < NLAYER * 2752) {
        TrDesc d; TrRegs r; tr_desc(p, bid, d); tr_load(d, tid, r);
        int buf = 0;
        for (int it = bid; it < NLAYER * 2752; it += nblk) {
            LAS float* tl = tile + buf * (64 * 65);
#pragma unroll
            for (int i = 0; i < 2; ++i) { const int idx = tid + i * 512, rr = idx >> 4, c4 = (idx & 15) * 4; const float g = r.g[i];
                tl[rr * 65 + c4 + 0] = r.v[i][0] * g; tl[rr * 65 + c4 + 1] = r.v[i][1] * g; tl[rr * 65 + c4 + 2] = r.v[i][2] * g; tl[rr * 65 + c4 + 3] = r.v[i][3] * g; }
            __syncthreads();
            const TrDesc dc = d;
            if (it + nblk < NLAYER * 2752) { tr_desc(p, it + nblk, d); tr_load(d, tid, r); }
            { const int n = tid >> 3, k8 = (tid & 7) * 8; u32x4 o;
#pragma unroll
              for (int e = 0; e < 4; ++e) o[e] = pk2(tl[(k8 + 2 * e) * 65 + n], tl[(k8 + 2 * e + 1) * 65 + n]);
              *(u32x4*)(dc.dst + (size_t)n * dc.ldd + k8) = o; }
            buf ^= 1;
        }
        __syncthreads();
    }
    {
        const int lane = tid & 63, wid = tid >> 6, fr = lane & 15, fq = lane >> 4;
        for (int it = bid; it < NLAYER * 4 * 16; it += nblk) {
            const int l = it >> 6, g = (it >> 4) & 3, k0 = (it & 15) * 64;
            const float* src = p.w_in + (size_t)l * DM * INC + g * 128;
            bf16_t* W = p.Wt + (size_t)l * W_LAYER + W_IN;
            const int rl = wid * 16 + fr, cc = rl <= 64 ? rl : rl - 64; const bool is_sin = rl >= 65;
            bf16x8 Bt[4];
#pragma unroll
            for (int ks = 0; ks < 4; ++ks) { float t[8];
#pragma unroll
                for (int e = 0; e < 8; ++e) { const int c = ks * 32 + fq * 8 + e; const float a = (float)((c * cc) & 127) * (1.f / 128.f);
                    t[e] = (is_sin ? __builtin_amdgcn_sinf(a) : __builtin_amdgcn_cosf(a)) * 0.08838834764831845f; }
                u32x4 o; o[0] = pk2(t[0], t[1]); o[1] = pk2(t[2], t[3]); o[2] = pk2(t[4], t[5]); o[3] = pk2(t[6], t[7]); Bt[ks] = __builtin_bit_cast(bf16x8, o); }
#pragma unroll
            for (int mb = 0; mb < 4; ++mb) {
                bf16x8 Af[4];
#pragma unroll
                for (int ks = 0; ks < 4; ++ks) { const float* pa = src + (size_t)(k0 + mb * 16 + fr) * INC + ks * 32 + fq * 8;
                    const f32x4 a0 = *(const f32x4*)pa, a1 = *(const f32x4*)(pa + 4);
                    u32x4 o; o[0] = pk2(a0[0], a0[1]); o[1] = pk2(a0[2], a0[3]); o[2] = pk2(a1[0], a1[1]); o[3] = pk2(a1[2], a1[3]); Af[ks] = __builtin_bit_cast(bf16x8, o); }
                const f32x4 gn = *(const f32x4*)(p.norm_mix_pre + l * DM + k0 + mb * 16 + 4 * fq);
                f32x4 acc = (f32x4){0.f, 0.f, 0.f, 0.f};
#pragma unroll
                for (int ks = 0; ks < 4; ++ks) acc = MFMA16(Af[ks], Bt[ks], acc);
                u32x2 o; o[0] = pk2(acc[0] * gn[0], acc[1] * gn[1]); o[1] = pk2(acc[2] * gn[2], acc[3] * gn[3]);
                *(u32x2*)(W + (size_t)(g * 128 + rl) * 1024 + k0 + mb * 16 + 4 * fq) = o;
            }
        }
    }
    for (int it = bid; it < NLAYER * 2 * 2 * 32; it += nblk) {
        const int jc = it & 31, kh = (it >> 5) & 1, fb = (it >> 6) & 1, l = it >> 7, k = kh * 512 + tid;
        const float* wr_ = p.w_in + (size_t)l * DM * INC + (size_t)k * INC + 2048 + fb * 16;
        float w[16];
#pragma unroll
        for (int r4 = 0; r4 < 4; ++r4) { const f32x4 v = *(const f32x4*)(wr_ + r4 * 4); w[r4 * 4] = v[0]; w[r4 * 4 + 1] = v[1]; w[r4 * 4 + 2] = v[2]; w[r4 * 4 + 3] = v[3]; }
        const float gain = p.norm_mix_pre[l * DM + k];
        const float* wa = (fb ? p.w_ab : p.w_af) + (size_t)l * 16 * 256 + jc * 8;
        bf16_t* dst = p.Wt + (size_t)l * W_LAYER + W_IN + (size_t)(2560 + fb * 256 + jc * 8) * 1024 + k;
#pragma unroll
        for (int j = 0; j < 8; ++j) { float sacc = 0.f;
#pragma unroll
            for (int r = 0; r < 16; ++r) sacc += w[r] * wa[r * 256 + j];
            dst[(size_t)j * 1024] = f2bf(sacc * gain); }
    }
    for (int id = bid * NTHREADS + tid; id < 3 * 8192; id += nblk * NTHREADS) {
        const int t = id >> 13, k = (id >> 7) & 63, K = id & 127, reim = K >> 6, n = K & 63;
        const float a = (float)((k * n) & 63) * (1.f / 64.f), c = __builtin_amdgcn_cosf(a) * 0.125f, sn = __builtin_amdgcn_sinf(a) * 0.125f;
        const float v = t == 0 ? (reim ? -sn : c) : (t == 1 ? (reim ? -c : -sn) : (reim ? sn : c));
        p.FT[id] = f2bf(v);
    }
    {
        const int lane = tid & 63, wid = tid >> 6;
        for (int row = bid * 8 + wid; row < NTOK; row += nblk * 8) {
            const float* xr = p.x + (size_t)row * DM; float ss = 0.f; f32x4 v[4];
#pragma unroll
            for (int i = 0; i < 4; ++i) { v[i] = *(const f32x4*)(xr + i * 256 + lane * 4); ss += v[i][0] * v[i][0] + v[i][1] * v[i][1] + v[i][2] * v[i][2] + v[i][3] * v[i][3]; }
#pragma unroll
            for (int o = 32; o > 0; o >>= 1) ss += __shfl_xor(ss, o);
#pragma unroll
            for (int i = 0; i < 4; ++i) { u32x2 o; o[0] = pk2(v[i][0], v[i][1]); o[1] = pk2(v[i][2], v[i][3]); *(u32x2*)(p.XB + (size_t)row * DM + i * 256 + lane * 4) = o; }
            if (lane == 0) *(f32x4*)(p.rstd + (size_t)row * 4) = (f32x4){ss, 0.f, 0.f, 0.f};
        }
    }
}

__device__ void phase_row(const Params& p, const float* xin_f32, const float* wpost, bool last, int bid, int nblk) {
    const int tid = tid_(), lane = tid & 63, wid = tid >> 6;
    for (int row = bid * 8 + wid; row < NTOK; row += nblk * 8) {
        const f32x4 s0 = *(const f32x4*)(p.ssqp + (size_t)row * 16), s1 = *(const f32x4*)(p.ssqp + (size_t)row * 16 + 4), s2 = *(const f32x4*)(p.ssqp + (size_t)row * 16 + 8), s3 = *(const f32x4*)(p.ssqp + (size_t)row * 16 + 12);
        float sm = 0.f;
#pragma unroll
        for (int j = 0; j < 4; ++j) sm += s0[j] + s1[j] + s2[j] + s3[j];
        const float rm = rsqrtf(sm * (1.f / 1024.f) + 1e-6f);
        float ss = 0.f; float v[2][8];
#pragma unroll
        for (int i = 0; i < 2; ++i) { const int c = i * 512 + lane * 8;
            const u32x4 mv = *(const u32x4*)(p.MF + (size_t)row * DM + c);
            const f32x4 w0 = *(const f32x4*)(wpost + c), w1 = *(const f32x4*)(wpost + c + 4);
            float xv[8];
            if (xin_f32) { const f32x4 x0 = *(const f32x4*)(xin_f32 + (size_t)row * DM + c), x1 = *(const f32x4*)(xin_f32 + (size_t)row * DM + c + 4);
#pragma unroll
                for (int j = 0; j < 4; ++j) { xv[j] = x0[j]; xv[4 + j] = x1[j]; } }
            else { const u32x4 xb = *(const u32x4*)(p.XB + (size_t)row * DM + c);
#pragma unroll
                for (int j = 0; j < 4; ++j) { xv[2 * j] = bflo(xb[j]); xv[2 * j + 1] = bfhi(xb[j]); } }
#pragma unroll
            for (int j = 0; j < 4; ++j) { v[i][2 * j] = xv[2 * j] + bflo(mv[j]) * rm * (j < 2 ? w0[2 * j] : w1[2 * j - 4]); v[i][2 * j + 1] = xv[2 * j + 1] + bfhi(mv[j]) * rm * (j < 2 ? w0[2 * j + 1] : w1[2 * j - 3]); }
#pragma unroll
            for (int j = 0; j < 8; ++j) ss += v[i][j] * v[i][j]; }
#pragma unroll
        for (int o = 32; o > 0; o >>= 1) ss += __shfl_xor(ss, o);
#pragma unroll
        for (int i = 0; i < 2; ++i) { const int c = i * 512 + lane * 8;
            if (last) { *(f32x4*)(p.out + (size_t)row * DM + c) = (f32x4){v[i][0], v[i][1], v[i][2], v[i][3]}; *(f32x4*)(p.out + (size_t)row * DM + c + 4) = (f32x4){v[i][4], v[i][5], v[i][6], v[i][7]}; }
            else { u32x4 o; o[0] = pk2(v[i][0], v[i][1]); o[1] = pk2(v[i][2], v[i][3]); o[2] = pk2(v[i][4], v[i][5]); o[3] = pk2(v[i][6], v[i][7]); *(u32x4*)(p.XB + (size_t)row * DM + c) = o; } }
        if (lane == 0 && !last) p.rstd[row] = rsqrtf(ss * (1.f / 1024.f) + 1e-6f);
    }
}

typedef const LAS bf16x8* lbp;

__device__ __forceinline__ float logsig16(float z) { return (fminf(z, 0.f) - __logf(1.f + __expf(-fabsf(z)))) * 0.0625f; }
__device__ __forceinline__ float silu_f(float g) { return g * __builtin_amdgcn_rcpf(1.f + __builtin_amdgcn_exp2f(g * -1.4426950408889634f)); }
struct GlaRegs { u32x4 rf, rb, va, vc, rq, rk, g0, g1; };
template <bool WITH_QG>
__device__ __forceinline__ void gla_issue(const Params& p, int tile, int tid, GlaRegs& r) {
    const int bh = tile >> 6, n = tile & 63, b = bh >> 2, h = bh & 3;
    const size_t tok0 = (size_t)b * 4096 + n * 64;
    const int j = tid >> 3, d0 = (tid & 7) * 8, v0 = (tid & 7) * 16;
    r.rf = *(const u32x4*)(p.LAF + (tok0 + j) * 256 + h * 64 + d0); r.rb = *(const u32x4*)(p.LAB + (tok0 + j) * 256 + h * 64 + d0);
    const bf16_t* pv = p.V + (tok0 + j) * 512 + h * 128 + v0;
    r.va = *(const u32x4*)pv; r.vc = *(const u32x4*)(pv + 8);
    r.rk = *(const u32x4*)(p.K + (tok0 + j) * 256 + h * 64 + d0);
    if (WITH_QG) { r.rq = *(const u32x4*)(p.Q + (tok0 + j) * 256 + h * 64 + d0);
        const bf16_t* pg = p.G + (tok0 + j) * 512 + h * 128 + v0; r.g0 = *(const u32x4*)pg; r.g1 = *(const u32x4*)(pg + 8); }
}
__device__ __forceinline__ void gla_load_scan(const GlaRegs& r, int tid, LAS float* cumf, LAS float* cumb, LAS float* segs, LAS bf16_t* vT) {
    { const int j = tid >> 3, d0 = (tid & 7) * 8;
      const u32x4 rf = r.rf, rb = r.rb;
#pragma unroll
      for (int e = 0; e < 4; ++e) { cumf[j * 65 + d0 + 2 * e] = logsig16(bflo(rf[e])); cumf[j * 65 + d0 + 2 * e + 1] = logsig16(bfhi(rf[e])); cumb[j * 65 + d0 + 2 * e] = logsig16(bflo(rb[e])); cumb[j * 65 + d0 + 2 * e + 1] = logsig16(bfhi(rb[e])); }
      const int v0 = (tid & 7) * 16;
      const u32x4 a = r.va, c = r.vc;
#pragma unroll
      for (int e = 0; e < 4; ++e) { vT[(v0 + 2 * e) * 72 + j] = (bf16_t)(a[e] & 0xffffu); vT[(v0 + 2 * e + 1) * 72 + j] = (bf16_t)(a[e] >> 16);
                                    vT[(v0 + 8 + 2 * e) * 72 + j] = (bf16_t)(c[e] & 0xffffu); vT[(v0 + 8 + 2 * e + 1) * 72 + j] = (bf16_t)(c[e] >> 16); }
    }
    __syncthreads();
    const int dir = tid >> 8, seg = (tid >> 6) & 3, d = tid & 63;
    LAS float* c = dir ? cumb : cumf;
    float c16[16];
#pragma unroll
    for (int jj = 0; jj < 16; ++jj) c16[jj] = c[(seg * 16 + jj) * 65 + d];
    if (!dir) {
#pragma unroll
        for (int jj = 1; jj < 16; ++jj) c16[jj] += c16[jj - 1];
        segs[seg * 64 + d] = c16[15];
    } else {
#pragma unroll
        for (int jj = 14; jj >= 0; --jj) c16[jj] += c16[jj + 1];
        segs[(4 + seg) * 64 + d] = c16[0];
    }
    __syncthreads();
    { float off = 0.f;
      if (!dir) { for (int s = 0; s < seg; ++s) off += segs[s * 64 + d]; }
      else { for (int s = 3; s > seg; --s) off += segs[(4 + s) * 64 + d]; }
#pragma unroll
      for (int jj = 0; jj < 16; ++jj) c[(seg * 16 + jj) * 65 + d] = c16[jj] + off; }
    __syncthreads();
}

__device__ void phase_gla_state(const Params& p, LAS unsigned char* lds, int bid, int nblk) {
    const int tid = tid_(), lane = tid & 63, wid = tid >> 6, fr = lane & 15, fq = lane >> 4;
    LAS float* cumf = (LAS float*)lds; LAS float* cumb = cumf + 64 * 65; LAS float* segs = cumb + 64 * 65;
    LAS bf16_t* kTf = (LAS bf16_t*)(lds + 36864); LAS bf16_t* kTb = kTf + 64 * 72; LAS bf16_t* vT = (LAS bf16_t*)(lds + 82944);
    GlaRegs cur; gla_issue<false>(p, bid < 2048 ? bid : 0, tid, cur);
    for (int tile = bid; tile < 2048; tile += nblk) {
        GlaRegs nxt; gla_issue<false>(p, tile + nblk < 2048 ? tile + nblk : tile, tid, nxt);
        gla_load_scan(cur, tid, cumf, cumb, segs, vT);
        { const int j = tid >> 3, d0 = (tid & 7) * 8;
          const u32x4 rk = cur.rk;
#pragma unroll
          for (int e = 0; e < 8; ++e) { const int d = d0 + e; const float kv = (e & 1) ? bfhi(rk[e >> 1]) : bflo(rk[e >> 1]);
              kTf[d * 72 + j] = f2bf(kv * __expf(cumf[63 * 65 + d] - cumf[j * 65 + d]));
              kTb[d * 72 + j] = f2bf(kv * __expf(cumb[d] - cumb[j * 65 + d])); }
          if (tid < 64) { p.decf[(size_t)tile * 64 + tid] = __expf(cumf[63 * 65 + tid]); p.decb[(size_t)tile * 64 + tid] = __expf(cumb[tid]); }
        }
        __syncthreads();
        { const int dir = wid >> 2, rb = wid & 3;
          LAS bf16_t* kT = dir ? kTb : kTf; bf16_t* CS = (dir ? p.CSB : p.CSF) + (size_t)tile * 8192;
          bf16x8 a[2];
#pragma unroll
          for (int s = 0; s < 2; ++s) a[s] = *(lbp)(kT + (rb * 16 + fr) * 72 + s * 32 + fq * 8);
#pragma unroll
          for (int cb = 0; cb < 8; ++cb) { f32x4 c = (f32x4){0.f, 0.f, 0.f, 0.f};
#pragma unroll
              for (int s = 0; s < 2; ++s) c = MFMA16(a[s], *(lbp)(vT + (cb * 16 + fr) * 72 + s * 32 + fq * 8), c);
              u32x2 o; o[0] = pk2(c[0], c[1]); o[1] = pk2(c[2], c[3]);
              *(u32x2*)(CS + (size_t)(cb * 16 + fr) * 64 + rb * 16 + fq * 4) = o; }
        }
        __syncthreads();
        cur = nxt;
    }
}

__device__ void phase_gla_scan(const Params& p, int bid, int nblk) {
    for (int id = bid * NTHREADS + tid_(); id < 2 * 32 * 2048; id += nblk * NTHREADS) {
        const int dir = id >> 16, bh = (id >> 11) & 31, e = (id & 2047) * 4, d = e & 63;
        bf16_t* cs = (dir ? p.CSB : p.CSF) + (size_t)bh * 64 * 8192 + e;
        const float* dec = (dir ? p.decb : p.decf) + (size_t)bh * 64 * 64 + d;
        f32x4 st = (f32x4){0.f, 0.f, 0.f, 0.f};
        for (int n0 = 0; n0 < 64; n0 += 8) {
            u32x2 c[8]; f32x4 dc[8];
#pragma unroll
            for (int i = 0; i < 8; ++i) { const int n = dir ? 63 - (n0 + i) : n0 + i; c[i] = *(const u32x2*)(cs + (size_t)n * 8192); dc[i] = *(const f32x4*)(dec + n * 64); }
#pragma unroll
            for (int i = 0; i < 8; ++i) { const int n = dir ? 63 - (n0 + i) : n0 + i;
                u32x2 o; o[0] = pk2(st[0], st[1]); o[1] = pk2(st[2], st[3]); *(u32x2*)(cs + (size_t)n * 8192) = o;
                st[0] = st[0] * dc[i][0] + bflo(c[i][0]); st[1] = st[1] * dc[i][1] + bfhi(c[i][0]); st[2] = st[2] * dc[i][2] + bflo(c[i][1]); st[3] = st[3] * dc[i][3] + bfhi(c[i][1]); }
        }
    }
}

__device__ void phase_gla_out(const Params& p, int layer, LAS unsigned char* lds, int bid, int nblk) {
    const int tid = tid_(), lane = tid & 63, wid = tid >> 6, fr = lane & 15, fq = lane >> 4;
    LAS float* cumf = (LAS float*)lds; LAS float* cumb = cumf + 64 * 65; LAS float* segs = cumb + 64 * 65; LAS float* o_l = (LAS float*)lds;
    LAS bf16_t* qef = (LAS bf16_t*)(lds + 36864); LAS bf16_t* kef = qef + 64 * 72; LAS bf16_t* qeb = kef + 64 * 72; LAS bf16_t* keb = qeb + 64 * 72; LAS bf16_t* att = keb + 64 * 72;
    LAS bf16_t* vT = (LAS bf16_t*)(lds + 82944);
    bf16_t* MIX = p.MIX;
    GlaRegs cur; gla_issue<true>(p, bid < 2048 ? bid : 0, tid, cur);
    for (int tile = bid; tile < 2048; tile += nblk) {
        const int bh = tile >> 6, n = tile & 63, b = bh >> 2, h = bh & 3;
        const size_t tok0 = (size_t)b * 4096 + n * 64;
        const int rb = wid & 3;
        bf16x8 pfr[4][2], pbr[4][2];
        { const bf16_t* pf = p.CSF + (size_t)tile * 8192; const bf16_t* pb = p.CSB + (size_t)tile * 8192;
#pragma unroll
          for (int cb = 0; cb < 4; ++cb)
#pragma unroll
              for (int s = 0; s < 2; ++s) { const int vv = (wid >> 2) * 64 + cb * 16 + fr;
                  pfr[cb][s] = *(const bf16x8*)(pf + (size_t)vv * 64 + s * 32 + fq * 8); pbr[cb][s] = *(const bf16x8*)(pb + (size_t)vv * 64 + s * 32 + fq * 8); } }
        GlaRegs nxt; gla_issue<true>(p, tile + nblk < 2048 ? tile + nblk : tile, tid, nxt);
        gla_load_scan(cur, tid, cumf, cumb, segs, vT);
        { const int j = tid >> 3, d0 = (tid & 7) * 8;
          const u32x4 rq = cur.rq, rk = cur.rk;
          u32x4 oqf, okf, oqb, okb;
#pragma unroll
          for (int e = 0; e < 4; ++e) {
              const float cf0 = cumf[j * 65 + d0 + 2 * e], cf1 = cumf[j * 65 + d0 + 2 * e + 1], cb0 = cumb[j * 65 + d0 + 2 * e], cb1 = cumb[j * 65 + d0 + 2 * e + 1];
              const float q0 = bflo(rq[e]), q1 = bfhi(rq[e]), k0 = bflo(rk[e]), k1 = bfhi(rk[e]);
              oqf[e] = pk2(q0 * __expf(cf0), q1 * __expf(cf1)); okf[e] = pk2(k0 * __expf(-cf0), k1 * __expf(-cf1));
              oqb[e] = pk2(q0 * __expf(cb0), q1 * __expf(cb1)); okb[e] = pk2(k0 * __expf(-cb0), k1 * __expf(-cb1)); }
          *(LAS u32x4*)(qef + j * 72 + d0) = oqf; *(LAS u32x4*)(kef + j * 72 + d0) = okf; *(LAS u32x4*)(qeb + j * 72 + d0) = oqb; *(LAS u32x4*)(keb + j * 72 + d0) = okb;
        }
        __syncthreads();
        bf16x8 aqf[2], aqb[2];
#pragma unroll
        for (int s = 0; s < 2; ++s) { aqf[s] = *(lbp)(qef + (rb * 16 + fr) * 72 + s * 32 + fq * 8); aqb[s] = *(lbp)(qeb + (rb * 16 + fr) * 72 + s * 32 + fq * 8); }
#pragma unroll
        for (int jj = 0; jj < 2; ++jj) { const int bj = (wid >> 2) * 2 + jj;
            f32x4 cf = (f32x4){0.f, 0.f, 0.f, 0.f}, cbk = cf;
#pragma unroll
            for (int s = 0; s < 2; ++s) { cf = MFMA16(aqf[s], *(lbp)(kef + (bj * 16 + fr) * 72 + s * 32 + fq * 8), cf); cbk = MFMA16(aqb[s], *(lbp)(keb + (bj * 16 + fr) * 72 + s * 32 + fq * 8), cbk); }
#pragma unroll
            for (int r = 0; r < 4; ++r) { const int i = rb * 16 + fq * 4 + r, j = bj * 16 + fr;
                const float val = j < i ? cf[r] : (j > i ? cbk[r] : cf[r] + cbk[r]); att[i * 72 + j] = f2bf(val); } }
        __syncthreads();
        { const int chh = wid >> 2;
          bf16x8 aat[2];
#pragma unroll
          for (int s = 0; s < 2; ++s) aat[s] = *(lbp)(att + (rb * 16 + fr) * 72 + s * 32 + fq * 8);
#pragma unroll
          for (int cb = 0; cb < 4; ++cb) { const int vvb = chh * 64 + cb * 16; f32x4 a = (f32x4){0.f, 0.f, 0.f, 0.f};
#pragma unroll
              for (int s = 0; s < 2; ++s) a = MFMA16(aat[s], *(lbp)(vT + (vvb + fr) * 72 + s * 32 + fq * 8), a);
#pragma unroll
              for (int s = 0; s < 2; ++s) a = MFMA16(aqf[s], pfr[cb][s], a);
#pragma unroll
              for (int s = 0; s < 2; ++s) a = MFMA16(aqb[s], pbr[cb][s], a);
#pragma unroll
              for (int r = 0; r < 4; ++r) o_l[(rb * 16 + fq * 4 + r) * 132 + vvb + fr] = a[r]; }
        }
        __syncthreads();
        { const int i = tid >> 3, seg = tid & 7; float v[16]; float ss = 0.f;
#pragma unroll
          for (int e4 = 0; e4 < 4; ++e4) { const f32x4 t = *(const LAS f32x4*)(o_l + i * 132 + seg * 16 + e4 * 4);
#pragma unroll
              for (int e = 0; e < 4; ++e) { v[e4 * 4 + e] = t[e]; ss += t[e] * t[e]; } }
          ss += __shfl_xor(ss, 1); ss += __shfl_xor(ss, 2); ss += __shfl_xor(ss, 4);
          const float rs = rsqrtf(ss * (1.f / 128.f) + 1e-6f);
          const u32x4 g0 = cur.g0, g1 = cur.g1;
          const float* wn = p.onorm + layer * 128 + seg * 16;
          u32x4 o0, o1;
#pragma unroll
          for (int e = 0; e < 4; ++e) {
              o0[e] = pk2(v[2 * e] * rs * wn[2 * e] * silu_f(bflo(g0[e])), v[2 * e + 1] * rs * wn[2 * e + 1] * silu_f(bfhi(g0[e])));
              o1[e] = pk2(v[8 + 2 * e] * rs * wn[8 + 2 * e] * silu_f(bflo(g1[e])), v[8 + 2 * e + 1] * rs * wn[8 + 2 * e + 1] * silu_f(bfhi(g1[e]))); }
          bf16_t* po = MIX + (tok0 + i) * 1024 + 512 + h * 128 + seg * 16;
          *(u32x4*)po = o0; *(u32x4*)(po + 8) = o1;
        }
        __syncthreads();
        cur = nxt;
    }
}

__device__ __forceinline__ int zt_off(int reim, int n2, int n1) { return reim * 4096 + n2 * 64 + ((((n1 >> 3) ^ n2 ^ (n2 >> 3)) & 7) << 3) + (n1 & 7); }
__device__ __forceinline__ int bl_off(int k1, int K) { return k1 * 128 + ((((K >> 3) ^ k1) & 15) << 3) + (K & 7); }
#define CFR(kb, ks) (*(lbp)(tab + ((kb) * 16 + fr) * 64 + ((((ks) * 4 + fq) ^ ((fr >> 1) & 7)) << 3)))
#define SFR(kb, ks) (*(lbp)(tab + 4096 + ((kb) * 16 + fr) * 64 + ((((ks) * 4 + fq) ^ ((fr >> 1) & 7)) << 3)))
#define NEG8(x) __builtin_bit_cast(bf16x8, __builtin_bit_cast(u32x4, (x)) ^ (u32x4){0x80008000u, 0x80008000u, 0x80008000u, 0x80008000u})
__device__ __forceinline__ void fft_wave(const bf16_t* cosrow, const bf16_t* sinrow, bool szero, LAS bf16_t* R, LAS bf16_t* tab, int lane, f32x4 (&Y)[4][4]) {
    const int fr = lane & 15, fq = lane >> 4;
#pragma unroll
    for (int reim = 0; reim < 2; ++reim) {
        const bf16_t* src = reim ? sinrow : cosrow;
#pragma unroll
        for (int it = 0; it < 8; ++it) { const int q = it * 64 + lane, n1 = q >> 3, n20 = (q & 7) * 8;
            u32x4 v = *(const u32x4*)(src + q * 8);
            if (reim && szero) v = (u32x4){0u, 0u, 0u, 0u};
#pragma unroll
            for (int e = 0; e < 4; ++e) { R[zt_off(reim, n20 + 2 * e, n1)] = (bf16_t)(v[e] & 0xffffu); R[zt_off(reim, n20 + 2 * e + 1, n1)] = (bf16_t)(v[e] >> 16); } } }
    bf16x8 Bz[4][4];
#pragma unroll
    for (int n2b = 0; n2b < 4; ++n2b)
#pragma unroll
        for (int ks = 0; ks < 4; ++ks) Bz[n2b][ks] = *(lbp)(R + zt_off(ks >> 1, n2b * 16 + fr, (ks & 1) * 32 + fq * 8));
#pragma unroll
    for (int k1b = 0; k1b < 4; ++k1b) {
        bf16x8 Ar[4], Ai[4];
        Ar[0] = CFR(k1b, 0); Ar[1] = CFR(k1b, 1); Ar[2] = NEG8(SFR(k1b, 0)); Ar[3] = NEG8(SFR(k1b, 1));
        Ai[0] = Ar[2]; Ai[1] = Ar[3]; Ai[2] = NEG8(Ar[0]); Ai[3] = NEG8(Ar[1]);
#pragma unroll
        for (int n2b = 0; n2b < 4; ++n2b) {
            f32x4 aR = (f32x4){0.f, 0.f, 0.f, 0.f}, aI = aR;
#pragma unroll
            for (int ks = 0; ks < 4; ++ks) { aR = MFMA16(Ar[ks], Bz[n2b][ks], aR); aI = MFMA16(Ai[ks], Bz[n2b][ks], aI); }
#pragma unroll
            for (int j = 0; j < 4; ++j) { const int k1 = k1b * 16 + 4 * fq + j, n2 = n2b * 16 + fr;
                const float ang = (float)((k1 * n2) & 4095) * (1.f / 4096.f), tc = __builtin_amdgcn_cosf(ang), ts = __builtin_amdgcn_sinf(ang);
                R[bl_off(k1, n2)] = f2bf(aR[j] * tc + aI[j] * ts); R[bl_off(k1, 64 + n2)] = f2bf(aI[j] * tc - aR[j] * ts); }
        }
    }
#pragma unroll
    for (int k2b = 0; k2b < 4; ++k2b) {
        bf16x8 Tb[4];
        Tb[0] = CFR(k2b, 0); Tb[1] = CFR(k2b, 1); Tb[2] = SFR(k2b, 0); Tb[3] = SFR(k2b, 1);
#pragma unroll
        for (int k1b = 0; k1b < 4; ++k1b) { f32x4 a = (f32x4){0.f, 0.f, 0.f, 0.f};
#pragma unroll
            for (int ks = 0; ks < 4; ++ks) a = MFMA16(*(lbp)(R + bl_off(k1b * 16 + fr, ks * 32 + fq * 8)), Tb[ks], a);
            Y[k1b][k2b] = a; }
    }
}
__device__ __forceinline__ void fft_put(LAS bf16_t* plane, int lane, const f32x4 (&Y)[4][4]) {
    const int fr = lane & 15, fq = lane >> 4;
#pragma unroll
    for (int k1b = 0; k1b < 4; ++k1b)
#pragma unroll
        for (int k2b = 0; k2b < 4; ++k2b)
#pragma unroll
            for (int j = 0; j < 4; ++j) plane[(k1b * 16 + 4 * fq + j) * 68 + k2b * 16 + fr] = f2bf(Y[k1b][k2b][j]);
}
__device__ void phase_fft(const Params& p, LAS unsigned char* lds, int bid, int nblk) {
    const int wid = __builtin_amdgcn_readfirstlane(threadIdx.x >> 6);
    LAS bf16_t* R = (LAS bf16_t*)(lds + wid * 16384);
    LAS bf16_t* YL = (LAS bf16_t*)lds;
    LAS bf16_t* P0 = (LAS bf16_t*)(lds + LDS_TAB + 16384);
    LAS bf16_t* tab = (LAS bf16_t*)(lds + LDS_TAB);
    { const int t0 = tid_();
#pragma unroll
      for (int i = 0; i < 2; ++i) { const int q = t0 + 512 * i, tb = q >> 9, row = (q >> 3) & 63, ch = q & 7;
          *(LAS u32x4*)(tab + tb * 4096 + row * 64 + ((ch ^ ((row >> 1) & 7)) << 3)) = *(const u32x4*)(p.FT + 16384 + row * 128 + tb * 64 + ch * 8); }
      __syncthreads(); }
    for (int r = 0;; ++r) {
        const int tid = tid_(), lane = tid & 63;
        int item;
        if (nblk == 256) { if (r >= 1) break; const int xcd = bid & 7, slot = bid >> 3; item = (xcd * 4 + (slot >> 3)) * 8 + (slot & 7); }
        else { item = bid + r * nblk; if (item >= 256) break; }
        const int bg = item >> 3, b = bg >> 2, g = bg & 3, i = item & 7, cp = 8 * i + wid;
        const bf16_t* rows = p.GT + ((size_t)b * 512 + g * 128) * 4096;
        f32x4 Y[4][4];
        const int npass = (wid == 0 && i == 0) ? 2 : 1;
#pragma unroll 1
        for (int pass = 0; pass < npass; ++pass) {
            const int cq = pass ? 64 : cp; const bool sz = (cq == 0) || (cq == 64);
            int ln = lane; asm volatile("" : "+v"(ln));
            fft_wave(rows + (size_t)cq * 4096, rows + (size_t)(sz ? 65 : 64 + cq) * 4096, sz, R, tab, ln, Y);
            if (wid == 0 && pass == 0) fft_put(P0, ln, Y);
        }
        __syncthreads();
        if (wid != 0 || i == 0) fft_put(YL + wid * 4352, lane, Y);
        __syncthreads();
        { const int k2 = tid & 63;
          bf16_t* dst = p.MIX + (size_t)b * 4096 * 1024 + g * 128 + 8 * i;
#pragma unroll 1
          for (int ii = 0; ii < 8; ++ii) { const int k1 = (tid >> 6) + 8 * ii, own = k1 * 68 + k2;
              const int k1m = (64 - k1) & 63, k2m = k1 == 0 ? ((64 - k2) & 63) : 63 - k2, mir = k1m * 68 + k2m;
              u32x4 o, m;
              o[0] = (unsigned)P0[own] | ((unsigned)YL[4352 + own] << 16);
              m[0] = (unsigned)(i == 0 ? YL[own] : P0[mir]) | ((unsigned)YL[4352 + mir] << 16);
#pragma unroll
              for (int w2 = 1; w2 < 4; ++w2) { o[w2] = (unsigned)YL[(2 * w2) * 4352 + own] | ((unsigned)YL[(2 * w2 + 1) * 4352 + own] << 16);
                                               m[w2] = (unsigned)YL[(2 * w2) * 4352 + mir] | ((unsigned)YL[(2 * w2 + 1) * 4352 + mir] << 16); }
              bf16_t* pt = dst + (size_t)(k1 + 64 * k2) * 1024;
              *(u32x4*)pt = o; *(u32x4*)(pt + 64) = m; } }
        __syncthreads();
    }
}

#define XB_TMO      128
#define XB_XCNT(j)  (256  + 64 * (j))
#define XB_XSUB(j)  (1280 + 64 * (j))
#define XB_XGEN(j)  (2304 + 64 * (j))
#define XB_TOP      3328
#define XB_TOPGEN   3392
#define XCD_BAR_WORDS 3456
#define XB_SPIN_CAP (1u << 22)
__device__ __forceinline__ unsigned xb_ld(unsigned* p)              { return __hip_atomic_load(p, __ATOMIC_RELAXED, __HIP_MEMORY_SCOPE_AGENT); }
__device__ __forceinline__ unsigned xb_add(unsigned* p, unsigned v) { return __hip_atomic_fetch_add(p, v, __ATOMIC_RELAXED, __HIP_MEMORY_SCOPE_AGENT); }
__device__ __forceinline__ unsigned xb_xcc_id() { return (unsigned)__builtin_amdgcn_s_getreg((3 << 11) | 20) & 0xFu; }
#define XB_SPIN(cond, bar) do { unsigned _sp = 0; while (cond) { __builtin_amdgcn_s_sleep(1); \
    if ((++_sp & 255u) == 0u) { if (xb_ld(&(bar)[XB_TMO])) break; if (_sp > XB_SPIN_CAP) { atomicAdd(&(bar)[XB_TMO], 1u); break; } } } } while (0)
struct XcdBarrier { unsigned* bar; unsigned x; volatile LAS unsigned* st; };
__device__ __forceinline__ XcdBarrier xcd_barrier_post(unsigned* bar, volatile LAS unsigned* st) {
    XcdBarrier b; b.bar = bar; b.x = xb_xcc_id(); b.st = st;
    if (threadIdx.x == 0) (void)xb_add(&bar[XB_XCNT(b.x)], 1u);
    return b;
}
__device__ __forceinline__ void xcd_barrier_complete(unsigned* bar, unsigned x, unsigned& nloc, unsigned& nx) {
    const unsigned G = gridDim.x * gridDim.y * gridDim.z;
    unsigned sum, cnt, mine, sp = 0u;
    for (;;) {
        sum = 0u; cnt = 0u; mine = 0u;
#pragma unroll
        for (unsigned j = 0; j < 16; ++j) { const unsigned c = xb_ld(&bar[XB_XCNT(j)]); sum += c; cnt += (c > 0u) ? 1u : 0u; mine = (j == x) ? c : mine; }
        if (sum == G) break;
        __builtin_amdgcn_s_sleep(1);
        if ((++sp & 255u) == 0u) { if (xb_ld(&bar[XB_TMO])) break; if (sp > XB_SPIN_CAP) { atomicAdd(&bar[XB_TMO], 1u); break; } }
    }
    nloc = mine > 0u ? mine : 1u; nx = cnt > 0u ? cnt : 1u;
}
__device__ __forceinline__ void xcd_barrier(const XcdBarrier& b) {
    asm volatile("s_waitcnt vmcnt(0)" ::: "memory");
    __syncthreads();
    if (threadIdx.x == 0) {
        unsigned* bar = b.bar;
        __builtin_amdgcn_s_waitcnt(0);
        unsigned nloc = b.st[0], nx = b.st[1];
        if (nloc == 0u) { xcd_barrier_complete(bar, b.x, nloc, nx); b.st[0] = nloc; b.st[1] = nx; }
        const unsigned old = xb_add(&bar[XB_XSUB(b.x)], 1u);
        const unsigned gen = old / nloc;
        if (old + 1u == (gen + 1u) * nloc) {
            __builtin_amdgcn_fence(__ATOMIC_RELEASE, "agent");
            asm volatile("s_waitcnt vmcnt(0)" ::: "memory");
            const unsigned og = xb_add(&bar[XB_TOP], 1u);
            const unsigned tg = og / nx;
            if (og + 1u == (tg + 1u) * nx) xb_add(&bar[XB_TOPGEN], 1u);
            else XB_SPIN(xb_ld(&bar[XB_TOPGEN]) == tg, bar);
            __builtin_amdgcn_fence(__ATOMIC_ACQUIRE, "agent");
            xb_add(&bar[XB_XGEN(b.x)], 1u);
            asm volatile("s_waitcnt vmcnt(0)" ::: "memory");
        } else {
            XB_SPIN(xb_ld(&bar[XB_XGEN(b.x)]) == gen, bar);
            __builtin_amdgcn_fence(__ATOMIC_ACQUIRE, "agent");
            asm volatile("s_waitcnt vmcnt(0)" ::: "memory");
        }
    }
    __syncthreads();
}

constexpr int PH_PER_LAYER = 7, N_PHASES = 1 + NLAYER * PH_PER_LAYER;

__device__ __forceinline__ void run_phase(const Params& p, int ph, LAS unsigned char* lds, int bid, int nblk) {
    if (ph == 0) { phase_prep(p, lds, bid, nblk); return; }
    const int l = (ph - 1) / PH_PER_LAYER, s = (ph - 1) % PH_PER_LAYER;
    const bf16_t* W = p.Wt + (size_t)l * W_LAYER;
    constexpr int ALL = 1 << 30;
    switch (s) {
    case 0: {
        EpiIn E{EpiGT{p.GT, p.rstd}, EpiRest{p.Q, p.K, p.V, p.G, p.LAF, p.LAB, p.rstd, p.b_af + l * 256, p.b_ab + l * 256}};
        pg8::SchedInProj S{W + W_IN, p.XB, bid};
        pg8::gemm_phase<EpiIn, pg8::SchedInProj, 1024>(lds, S, E);
    } break;
    case 1: phase_gla_state(p, lds, bid, nblk); break;
    case 2: phase_fft(p, lds, bid, nblk); phase_gla_scan(p, bid, nblk); break;
    case 3: phase_gla_out(p, l, lds, bid, nblk); break;
    case 4: {
        EpiRes E{p.XB, p.out, p.norm_mix_post + l * DM, p.rstd, p.xch, (unsigned)(l * 2 + 1), 0};
        { pg8::SchedOne<NTOK, 1024, 1024> S{p.MIX, W + W_OUT, bid, 0, 2}; pg8::gemm_phase<EpiRes, pg8::SchedOne<NTOK, 1024, 1024>, 1024>(lds, S, E); }
    } break;
    case 5: { EpiGU E{p.HMID, p.rstd}; pg8::SchedOne<NTOK, 2 * DFF, 1024> S{p.XB, W + W_GU, bid, 0, ALL}; pg8::gemm_phase<EpiGU, pg8::SchedOne<NTOK, 2 * DFF, 1024>, 1024>(lds, S, E); } break;
    case 6: {
        EpiRes E{p.XB, p.out, p.norm_ffn_post + l * DM, p.rstd, p.xch, (unsigned)(l * 2 + 2), l == NLAYER - 1 ? 1 : 0};
        { pg8::SchedOne<NTOK, 1024, DFF> S{p.HMID, W + W_D, bid, 0, 2}; pg8::gemm_phase<EpiRes, pg8::SchedOne<NTOK, 1024, DFF>, DFF>(lds, S, E); }
    } break;
    }
}

#if !ONE_LAUNCH
__global__ void __launch_bounds__(512, 2) k_phase(Params p, int ph) {
    extern __shared__ __attribute__((aligned(16))) unsigned char shm[];
    run_phase(p, ph, (LAS unsigned char*)shm, blockIdx.x, gridDim.x);
}
#else
__global__ void __launch_bounds__(512, 2) k_mega(Params p) {
    extern __shared__ __attribute__((aligned(16))) unsigned char shm[];
    cg::grid_group grid = cg::this_grid();
    volatile LAS unsigned* st = (volatile LAS unsigned*)((LAS unsigned char*)shm + LDS_STAGE);
    if (threadIdx.x == 0) { st[0] = 0u; st[1] = 0u; st[2] = 0u; st[3] = 0u; }
    __syncthreads();
    const XcdBarrier xb = xcd_barrier_post(p.bar, st);
    for (int ph = 0; ph < N_PHASES; ++ph) {
        int bidv = blockIdx.x; asm volatile("" : "+s"(bidv));
        run_phase(p, ph, (LAS unsigned char*)shm, bidv, gridDim.x);
#if PROBE_DBL
        { const int s_ = ph ? (ph - 1) % PH_PER_LAYER : -1;
          const bool dbl = ((PROBE_DBL & 1) && ph == 0) || ((PROBE_DBL & 2) && (s_ == 1 || s_ == 3)) || ((PROBE_DBL & 4) && (s_ == 0 || s_ == 4 || s_ == 6 || s_ == 7)) || ((PROBE_DBL & 8) && s_ == 2) || ((PROBE_DBL & 16) && s_ == 6) || ((PROBE_DBL & 32) && s_ == 7) || ((PROBE_DBL & 64) && s_ == 0) || ((PROBE_DBL & 128) && s_ == 4);
          if (dbl) { xcd_barrier(xb); if (s_ == 2) phase_fft(p, (LAS unsigned char*)shm, blockIdx.x, gridDim.x); else run_phase(p, ph, (LAS unsigned char*)shm, blockIdx.x, gridDim.x); } }
#endif
        if (ph + 1 < N_PHASES) { if (ph == 0) grid.sync(); else xcd_barrier(xb); }
    }
}
#endif

extern "C" void kernel_launch(void* const* d_in, const int* in_sizes, int n_in, void* d_out, int out_size, void* d_ws, size_t ws_size, hipStream_t stream) {
    Params p{};
    p.x = (const float*)d_in[0]; p.norm_mix_pre = (const float*)d_in[1]; p.w_in = (const float*)d_in[2]; p.w_af = (const float*)d_in[3]; p.b_af = (const float*)d_in[4];
    p.w_ab = (const float*)d_in[5]; p.b_ab = (const float*)d_in[6]; p.onorm = (const float*)d_in[7]; p.w_out = (const float*)d_in[8]; p.norm_mix_post = (const float*)d_in[9];
    p.norm_ffn_pre = (const float*)d_in[10]; p.w_g = (const float*)d_in[11]; p.w_u = (const float*)d_in[12]; p.w_d = (const float*)d_in[13]; p.norm_ffn_post = (const float*)d_in[14];
    p.out = (float*)d_out;
    unsigned char* ws = (unsigned char*)d_ws; size_t o = 0;
    p.Wt = (bf16_t*)(ws + o); o += NLAYER * W_LAYER * 2;
    p.FT = (bf16_t*)(ws + o); o += (size_t)65536;
    p.XB = (bf16_t*)(ws + o); o += (size_t)NTOK * DM * 2;
    p.MIX = (bf16_t*)(ws + o); o += (size_t)NTOK * DM * 2;
    p.rstd = (float*)(ws + o); o += (size_t)NTOK * 4 * 4;

    p.ssqp = (float*)(ws + o); o += (size_t)NTOK * 16 * 4;
    p.decf = (float*)(ws + o); o += (size_t)2048 * 64 * 4;
    p.decb = (float*)(ws + o); o += (size_t)2048 * 64 * 4;
    p.bar = (unsigned*)(ws + o); o += (size_t)16384;
    p.xch = (unsigned*)(ws + o); o += (size_t)NTOK * 4 * 8;
    p.cnt = nullptr;
    unsigned char* T = ws + o;
    p.HMID = (bf16_t*)T;
    p.GT = (bf16_t*)T;
    p.Q = (bf16_t*)(T + 67108864); p.K = (bf16_t*)(T + 83886080); p.V = (bf16_t*)(T + 100663296); p.G = (bf16_t*)(T + 134217728);
    p.LAF = (bf16_t*)(T + 167772160); p.LAB = (bf16_t*)(T + 184549376); p.CSF = (bf16_t*)(T + 201326592); p.CSB = (bf16_t*)(T + 234881024);
    p.MF = (bf16_t*)(T + 184549376);
    const size_t need = o + 268435456;
    if (ws_size < need) { fprintf(stderr, "kernel_launch: workspace too small: %zu < %zu\n", ws_size, need); return; }
#if ONE_LAUNCH
    static int grid = 0;
    if (!grid) {
        int dev = 0, cus = 0, per_cu = 0;
        hipGetDevice(&dev); hipDeviceGetAttribute(&cus, hipDeviceAttributeMultiprocessorCount, dev);
        hipFuncSetAttribute((const void*)k_mega, hipFuncAttributeMaxDynamicSharedMemorySize, LDS_BYTES);
        hipOccupancyMaxActiveBlocksPerMultiprocessor(&per_cu, (const void*)k_mega, NTHREADS, LDS_BYTES);
        if (per_cu < 1) per_cu = 1;
        grid = cus * per_cu;
        if (grid > 256) grid = 256;
        if (grid != 256) { fprintf(stderr, "kernel_launch: this kernel needs exactly 256 co-resident workgroups (got %d); nothing launched\n", grid); grid = -1; }
    }
    if (grid < 0) return;
    hipMemsetAsync(p.bar, 0, 16384 + (size_t)NTOK * 4 * 8, stream);
    void* args[] = {&p};
    hipError_t e = hipLaunchCooperativeKernel((const void*)k_mega, dim3(grid), dim3(NTHREADS), args, LDS_BYTES, stream);
    if (e != hipSuccess) fprintf(stderr, "cooperative launch failed: %s (grid %d)\n", hipGetErrorString(e), grid);
#else
    hipFuncSetAttribute((const void*)k_phase, hipFuncAttributeMaxDynamicSharedMemorySize, LDS_BYTES);
    for (int ph = 0; ph < N_PHASES; ++ph) hipLaunchKernelGGL(k_phase, dim3(256), dim3(NTHREADS), LDS_BYTES, stream, p, ph);
#endif
}
```
